# Optimizing an MI355X kernel written in HIP

```python
import jax, jax.numpy as jnp
from jax import lax
import numpy as np

D_MODEL = 1024
BATCH = 2
SEQ = 8192
DEPTH = 4
DEC_BATCH = 16
DEC_SEQ = 16
PAST_LEN = 1024

CHUNK = 64
EPS = 1e-6
NEG_INF = -1e30
GDN_HEADS = 4
GDN_DK = 128
GDN_DV = 128
GDN_CONV = 4
GDN_QK = GDN_HEADS * GDN_DK
GDN_V = GDN_HEADS * GDN_DV
GDN_CONV_CH = 2 * GDN_QK + GDN_V
SWA_HEADS = 4
SWA_KV_HEADS = 2
SWA_GROUP = SWA_HEADS // SWA_KV_HEADS
SWA_HD = 64
WINDOW = 128
WIN_CHUNKS = WINDOW // CHUNK
SWA_Q = SWA_HEADS * SWA_HD
SWA_KV = SWA_KV_HEADS * SWA_HD
SC_WIDTH = 256
SC_CONV = 3
MEM_TOKENS = 256
MEM_HEADS = 4
MEM_HD = D_MODEL // MEM_HEADS
D_FF = 2816
FFN_CONV = 3
IN_SIZES = (GDN_CONV_CH, GDN_V, GDN_HEADS, GDN_HEADS, SWA_Q, SWA_KV, SWA_KV, SC_WIDTH, SC_WIDTH, SC_WIDTH)
D_IN = GDN_CONV_CH + GDN_V + 2 * GDN_HEADS + SWA_Q + 2 * SWA_KV + 3 * SC_WIDTH
MIX_WIDTH = GDN_V + SWA_Q + SC_WIDTH

kernel_name = "hymba_gdn_swa_shortconv_streaming_step"


def rmsnorm(x, g):
    xf = x.astype(jnp.float32)
    y = xf * lax.rsqrt(jnp.mean(xf * xf, axis=-1, keepdims=True) + EPS)
    return (y * g.astype(jnp.float32)).astype(x.dtype)


def l2norm(x):
    xf = x.astype(jnp.float32)
    return (xf * lax.rsqrt(jnp.sum(xf * xf, axis=-1, keepdims=True) + EPS)).astype(x.dtype)


def split_cols(a, sizes):
    out, o = [], 0
    for s in sizes:
        out.append(a[..., o:o + s])
        o += s
    return out


def causal_dwconv(x, buf, w):
    W = w.shape[0]
    T = x.shape[1]
    xp = jnp.concatenate([buf.astype(x.dtype), x], axis=1)
    y = xp[:, 0:T] * w[0]
    for i in range(1, W):
        y = y + xp[:, i:i + T] * w[i]
    return y, xp[:, T:]


def gated_delta(q, k, v, g, beta, S0):
    B, T, H, dk = q.shape
    dv = v.shape[-1]
    C = CHUNK if T % CHUNK == 0 else T
    N = T // C

    def blk(a):
        a = a.reshape((B, N, C, H) + a.shape[3:])
        return jnp.moveaxis(a, (1, 3), (0, 2))

    qf, kf, vf = (blk(a).astype(jnp.float32) for a in (q, k, v))
    gc = jnp.cumsum(blk(g).astype(jnp.float32), axis=-1)
    bt = blk(beta).astype(jnp.float32)
    idx = jnp.arange(C)
    strict = idx[:, None] > idx[None, :]
    incl = idx[:, None] >= idx[None, :]
    diff = gc[..., :, None] - gc[..., None, :]
    dec_strict = jnp.exp(jnp.where(strict, diff, NEG_INF))
    dec_incl = jnp.exp(jnp.where(incl, diff, NEG_INF))
    kk = jnp.einsum('nbhid,nbhjd->nbhij', kf, kf)
    lower = bt[..., :, None] * kk * dec_strict + jnp.eye(C, dtype=jnp.float32)
    rhs = jnp.concatenate([bt[..., None] * vf, (bt * jnp.exp(gc))[..., None] * kf], axis=-1)
    sol = lax.linalg.triangular_solve(lower, rhs, left_side=True, lower=True, unit_diagonal=True)
    u0, wk = sol[..., :dv], sol[..., dv:]
    qk = jnp.einsum('nbhid,nbhjd->nbhij', qf, kf) * dec_incl
    qg = qf * jnp.exp(gc)[..., None]
    kd = kf * jnp.exp(gc[..., -1:] - gc)[..., None]
    gl = jnp.exp(gc[..., -1])

    def step(S, xs):
        u0c, wc, qkc, qgc, kdc, glc = xs
        u = u0c - jnp.einsum('bhck,bhkv->bhcv', wc, S)
        o = jnp.einsum('bhck,bhkv->bhcv', qgc, S) + jnp.einsum('bhij,bhjv->bhiv', qkc, u)
        S = glc[..., None, None] * S + jnp.einsum('bhck,bhcv->bhkv', kdc, u)
        return S, o

    S, o = lax.scan(step, S0.astype(jnp.float32), (u0, wk, qk, qg, kd, gl))
    o = jnp.moveaxis(o, (0, 2), (1, 3)).reshape(B, T, H, dv)
    return o, S


def sink_probs(s, sinks):
    sk = sinks.astype(jnp.float32).reshape(SWA_KV_HEADS, SWA_GROUP)[:, :, None, None]
    m = jnp.maximum(jnp.max(s, axis=-1, keepdims=True), sk)
    p = jnp.exp(s - m)
    return p / (jnp.sum(p, axis=-1, keepdims=True) + jnp.exp(sk - m))


def swa_prompt(q, k, v, sinks):
    B, T = q.shape[:2]
    N = T // CHUNK
    qb = q.reshape(B, N, CHUNK, SWA_KV_HEADS, SWA_GROUP, SWA_HD)

    def band(a):
        ab = a.reshape(B, N, CHUNK, SWA_KV_HEADS, SWA_HD)
        ap = jnp.pad(ab, ((0, 0), (WIN_CHUNKS, 0), (0, 0), (0, 0), (0, 0)))
        return jnp.concatenate([ap[:, i:i + N] for i in range(WIN_CHUNKS + 1)], axis=2)

    kb, vb = band(k), band(v)
    key_chunk = jnp.arange(N)[:, None] + jnp.arange(WIN_CHUNKS + 1)[None, :] - WIN_CHUNKS
    valid = jnp.repeat(key_chunk >= 0, CHUNK, axis=1)
    s = jnp.einsum('bnqhgd,bnkhd->bnhgqk', qb, kb, preferred_element_type=jnp.float32) * (SWA_HD ** -0.5)
    s = jnp.where(valid[None, :, None, None, None, :], s, NEG_INF)
    p = sink_probs(s, sinks).astype(v.dtype)
    o = jnp.einsum('bnhgqk,bnkhd->bnqhgd', p, vb)
    return o.reshape(B, T, SWA_Q)


def swa_sample(q, k, v, k_past, v_past, sinks):
    B, T = q.shape[:2]
    qg = q.reshape(B, T, SWA_KV_HEADS, SWA_GROUP, SWA_HD)
    kk = jnp.concatenate([k_past.astype(k.dtype), k], axis=1)
    vv = jnp.concatenate([v_past.astype(v.dtype), v], axis=1)
    s = jnp.einsum('bqhgd,bkhd->bhgqk', qg, kk, preferred_element_type=jnp.float32) * (SWA_HD ** -0.5)
    p = sink_probs(s, sinks).astype(v.dtype)
    o = jnp.einsum('bhgqk,bkhd->bqhgd', p, vv)
    return o.reshape(B, T, SWA_Q)


def memory_kv(mem, lw):
    B, M, _ = mem.shape
    m = rmsnorm(mem, lw['mem_in_norm_g'])
    k = rmsnorm((m @ lw['w_mk']).reshape(B, M, MEM_HEADS, MEM_HD), lw['mem_k_norm_g'])
    v = (m @ lw['w_mv']).reshape(B, M, MEM_HEADS, MEM_HD)
    return k, v


def memory_attend(hn, mem_k, mem_v, lw):
    B, T, _ = hn.shape
    q = rmsnorm((hn @ lw['w_mq']).reshape(B, T, MEM_HEADS, MEM_HD), lw['mem_q_norm_g'])
    s = jnp.einsum('bqhd,bkhd->bhqk', q, mem_k.astype(q.dtype), preferred_element_type=jnp.float32) * (MEM_HD ** -0.5)
    p = jax.nn.softmax(s, axis=-1).astype(hn.dtype)
    o = jnp.einsum('bhqk,bkhd->bqhd', p, mem_v.astype(hn.dtype)).reshape(B, T, D_MODEL)
    return o @ lw['w_mo']


def trunk_layer(x, mem_k, mem_v, gdn_S0, gdn_buf, sc_buf, ffn_buf, swa_k_past, swa_v_past, lw):
    B, T, _ = x.shape
    xn = rmsnorm(x, lw['norm_mix_g'])
    (qkv_raw, z, a, b, sq, sk, sv, sc_b, sc_c, sc_h) = split_cols(xn @ lw['w_in'], IN_SIZES)
    qkv, gdn_buf_new = causal_dwconv(qkv_raw, gdn_buf, lw['w_gdn_conv'])
    qkv = jax.nn.silu(qkv)
    gq, gk, gv = split_cols(qkv, (GDN_QK, GDN_QK, GDN_V))
    gq = l2norm(gq.reshape(B, T, GDN_HEADS, GDN_DK)) * (GDN_DK ** -0.5)
    gk = l2norm(gk.reshape(B, T, GDN_HEADS, GDN_DK))
    gv = gv.reshape(B, T, GDN_HEADS, GDN_DV)
    log_decay = -jnp.exp(lw['gdn_a_log'].astype(jnp.float32)) * jax.nn.softplus(
        a.astype(jnp.float32) + lw['gdn_dt_bias'].astype(jnp.float32))
    beta = jax.nn.sigmoid(b.astype(jnp.float32))
    go, S = gated_delta(gq, gk, gv, log_decay, beta, gdn_S0)
    go = rmsnorm(go, lw['gdn_norm_g']) * jax.nn.silu(z.astype(jnp.float32).reshape(B, T, GDN_HEADS, GDN_DV))
    out_a = go.reshape(B, T, GDN_V).astype(x.dtype)
    sq = rmsnorm(sq.reshape(B, T, SWA_HEADS, SWA_HD), lw['swa_q_norm_g'])
    sk = rmsnorm(sk.reshape(B, T, SWA_KV_HEADS, SWA_HD), lw['swa_k_norm_g'])
    sv = sv.reshape(B, T, SWA_KV_HEADS, SWA_HD)
    if swa_k_past is None:
        out_b = swa_prompt(sq, sk, sv, lw['swa_sinks'])
    else:
        out_b = swa_sample(sq, sk, sv, swa_k_past, swa_v_past, lw['swa_sinks'])
    cu, sc_buf_new = causal_dwconv(sc_c * sc_h, sc_buf, lw['w_sc_conv'])
    out_c = sc_b * cu
    h = x + jnp.concatenate([out_a, out_b, out_c], axis=-1) @ lw['w_o']
    h = h + memory_attend(rmsnorm(h, lw['norm_mem_g']), mem_k, mem_v, lw)
    u, ffn_buf_new = causal_dwconv(rmsnorm(h, lw['norm_ffn_g']) @ lw['w_up'], ffn_buf, lw['w_ffn_conv'])
    ug, uv = split_cols(u, (D_FF, D_FF))
    h = h + (jax.nn.silu(ug) * uv) @ lw['w_down']
    return h, S.astype(x.dtype), gdn_buf_new, sc_buf_new, ffn_buf_new, sk, sv


def setup_inputs(seed: int = 0) -> dict:
    key = jax.random.key(seed)
    ks = iter(jax.random.split(key, 48))

    def nrm(shape, scale=1.0):
        return jax.random.normal(next(ks), shape, jnp.float32) * scale

    def dense(shape):
        return nrm(shape, shape[-2] ** -0.5)

    def gain(shape):
        return 1.0 + nrm(shape, 0.02)

    swa_buf = min(WINDOW, PAST_LEN)
    dt = jnp.exp(jax.random.uniform(next(ks), (DEPTH, GDN_HEADS), jnp.float32, np.log(1e-3), np.log(1e-1)))
    inputs = {
        'x_prompt': nrm((BATCH, SEQ, D_MODEL)),
        'x_sample': nrm((DEC_BATCH, DEC_SEQ, D_MODEL)),
        'mem_prompt': nrm((BATCH, MEM_TOKENS, D_MODEL)),
        'state_gdn': nrm((DEPTH, DEC_BATCH, GDN_HEADS, GDN_DK, GDN_DV), 0.1),
        'state_gdn_conv': nrm((DEPTH, DEC_BATCH, GDN_CONV - 1, GDN_CONV_CH)),
        'cache_swa_k': nrm((DEPTH, DEC_BATCH, swa_buf, SWA_KV_HEADS, SWA_HD)),
        'cache_swa_v': nrm((DEPTH, DEC_BATCH, swa_buf, SWA_KV_HEADS, SWA_HD)),
        'state_sc_conv': nrm((DEPTH, DEC_BATCH, SC_CONV - 1, SC_WIDTH)),
        'cache_mem_k': nrm((DEPTH, DEC_BATCH, MEM_TOKENS, MEM_HEADS, MEM_HD)),
        'cache_mem_v': nrm((DEPTH, DEC_BATCH, MEM_TOKENS, MEM_HEADS, MEM_HD)),
        'state_ffn_conv': nrm((DEPTH, DEC_BATCH, FFN_CONV - 1, 2 * D_FF)),
        'norm_mix_g': gain((DEPTH, D_MODEL)),
        'w_in': dense((DEPTH, D_MODEL, D_IN)),
        'w_gdn_conv': nrm((DEPTH, GDN_CONV, GDN_CONV_CH), GDN_CONV ** -0.5),
        'gdn_a_log': jnp.log(jax.random.uniform(next(ks), (DEPTH, GDN_HEADS), jnp.float32, 1.0, 16.0)),
        'gdn_dt_bias': dt + jnp.log(-jnp.expm1(-dt)),
        'gdn_norm_g': gain((DEPTH, GDN_DV)),
        'swa_q_norm_g': gain((DEPTH, SWA_HD)),
        'swa_k_norm_g': gain((DEPTH, SWA_HD)),
        'swa_sinks': nrm((DEPTH, SWA_HEADS), 0.5),
        'w_sc_conv': nrm((DEPTH, SC_CONV, SC_WIDTH), SC_CONV ** -0.5),
        'w_o': dense((DEPTH, MIX_WIDTH, D_MODEL)),
        'norm_mem_g': gain((DEPTH, D_MODEL)),
        'mem_in_norm_g': gain((DEPTH, D_MODEL)),
        'w_mq': dense((DEPTH, D_MODEL, D_MODEL)),
        'w_mk': dense((DEPTH, D_MODEL, D_MODEL)),
        'w_mv': dense((DEPTH, D_MODEL, D_MODEL)),
        'mem_q_norm_g': gain((DEPTH, MEM_HD)),
        'mem_k_norm_g': gain((DEPTH, MEM_HD)),
        'w_mo': dense((DEPTH, D_MODEL, D_MODEL)),
        'norm_ffn_g': gain((DEPTH, D_MODEL)),
        'w_up': dense((DEPTH, D_MODEL, 2 * D_FF)),
        'w_ffn_conv': nrm((DEPTH, FFN_CONV, 2 * D_FF), FFN_CONV ** -0.5),
        'w_down': dense((DEPTH, D_FF, D_MODEL)),
    }
    return inputs


def reference(x_prompt, x_sample, mem_prompt,
              state_gdn, state_gdn_conv, cache_swa_k, cache_swa_v, state_sc_conv,
              cache_mem_k, cache_mem_v, state_ffn_conv,
              norm_mix_g, w_in, w_gdn_conv, gdn_a_log, gdn_dt_bias, gdn_norm_g,
              swa_q_norm_g, swa_k_norm_g, swa_sinks, w_sc_conv, w_o,
              norm_mem_g, mem_in_norm_g, w_mq, w_mk, w_mv, mem_q_norm_g, mem_k_norm_g, w_mo,
              norm_ffn_g, w_up, w_ffn_conv, w_down):
    hp, hs = x_prompt, x_sample
    Bp, Tp, _ = x_prompt.shape
    keep = min(WINDOW, Tp)
    p_S, p_gb, p_sk, p_sv, p_sb, p_mk, p_mv, p_fb = [], [], [], [], [], [], [], []
    s_S, s_gb, s_sk, s_sv, s_sb, s_fb = [], [], [], [], [], []
    for l in range(DEPTH):
        lw = {
            'norm_mix_g': norm_mix_g[l], 'w_in': w_in[l], 'w_gdn_conv': w_gdn_conv[l],
            'gdn_a_log': gdn_a_log[l], 'gdn_dt_bias': gdn_dt_bias[l], 'gdn_norm_g': gdn_norm_g[l],
            'swa_q_norm_g': swa_q_norm_g[l], 'swa_k_norm_g': swa_k_norm_g[l], 'swa_sinks': swa_sinks[l],
            'w_sc_conv': w_sc_conv[l], 'w_o': w_o[l], 'norm_mem_g': norm_mem_g[l],
            'mem_in_norm_g': mem_in_norm_g[l], 'w_mq': w_mq[l], 'w_mk': w_mk[l], 'w_mv': w_mv[l],
            'mem_q_norm_g': mem_q_norm_g[l], 'mem_k_norm_g': mem_k_norm_g[l], 'w_mo': w_mo[l],
            'norm_ffn_g': norm_ffn_g[l], 'w_up': w_up[l], 'w_ffn_conv': w_ffn_conv[l], 'w_down': w_down[l],
        }
        mk, mv = memory_kv(mem_prompt, lw)
        dt_p = hp.dtype
        hp, S, gb, sb, fb, sk, sv = trunk_layer(
            hp, mk, mv,
            jnp.zeros((Bp, GDN_HEADS, GDN_DK, GDN_DV), dt_p),
            jnp.zeros((Bp, GDN_CONV - 1, GDN_CONV_CH), dt_p),
            jnp.zeros((Bp, SC_CONV - 1, SC_WIDTH), dt_p),
            jnp.zeros((Bp, FFN_CONV - 1, 2 * D_FF), dt_p),
            None, None, lw)
        p_S.append(S); p_gb.append(gb); p_sb.append(sb); p_fb.append(fb)
        p_sk.append(sk[:, Tp - keep:]); p_sv.append(sv[:, Tp - keep:])
        p_mk.append(mk); p_mv.append(mv)
        hs, S, gb, sb, fb, sk, sv = trunk_layer(
            hs, cache_mem_k[l], cache_mem_v[l], state_gdn[l], state_gdn_conv[l],
            state_sc_conv[l], state_ffn_conv[l], cache_swa_k[l], cache_swa_v[l], lw)
        s_S.append(S); s_gb.append(gb); s_sb.append(sb); s_fb.append(fb)
        s_sk.append(sk); s_sv.append(sv)
    y_prompt, y_sample = hp, hs
    p_state_gdn = jnp.stack(p_S)
    p_state_gdn_conv = jnp.stack(p_gb)
    p_cache_swa_k = jnp.stack(p_sk)
    p_cache_swa_v = jnp.stack(p_sv)
    p_state_sc_conv = jnp.stack(p_sb)
    p_cache_mem_k = jnp.stack(p_mk)
    p_cache_mem_v = jnp.stack(p_mv)
    p_state_ffn_conv = jnp.stack(p_fb)
    s_state_gdn = jnp.stack(s_S)
    s_state_gdn_conv = jnp.stack(s_gb)
    s_swa_k_new = jnp.stack(s_sk)
    s_swa_v_new = jnp.stack(s_sv)
    s_state_sc_conv = jnp.stack(s_sb)
    s_state_ffn_conv = jnp.stack(s_fb)
    return (y_prompt, y_sample,
            p_state_gdn, p_state_gdn_conv, p_cache_swa_k, p_cache_swa_v, p_state_sc_conv,
            p_cache_mem_k, p_cache_mem_v, p_state_ffn_conv,
            s_state_gdn, s_state_gdn_conv, s_swa_k_new, s_swa_v_new, s_state_sc_conv, s_state_ffn_conv)
```

```cpp
#include <hip/hip_runtime.h>
#include <cstdio>
#include <cstdint>
template <int MSK> __device__ __forceinline__ float sw_xor(float v) { return __int_as_float(__builtin_amdgcn_ds_swizzle(__float_as_int(v), (MSK << 10) | 0x1f)); }
template <int MSK> __device__ __forceinline__ float xadd(float v) { return v + sw_xor<MSK>(v); }
template <int MSK> __device__ __forceinline__ float xmax(float v) { return fmaxf(v, sw_xor<MSK>(v)); }
__device__ __forceinline__ float xadd32(float v) { const auto rr = __builtin_amdgcn_permlane32_swap(__float_as_uint(v), __float_as_uint(v), false, false); return __uint_as_float(rr[0]) + __uint_as_float(rr[1]); }
__device__ __forceinline__ float xmax32(float v) { const auto rr = __builtin_amdgcn_permlane32_swap(__float_as_uint(v), __float_as_uint(v), false, false); return fmaxf(__uint_as_float(rr[0]), __uint_as_float(rr[1])); }
namespace pg8 {
#define PG8_LAS __attribute__((address_space(3)))
typedef unsigned short bf16_t;
typedef short bf16x8 __attribute__((ext_vector_type(8)));
typedef float f32x4 __attribute__((ext_vector_type(4)));
typedef unsigned u32x4 __attribute__((ext_vector_type(4)));
constexpr int BM = 256, BK = 64, HALF = 128, HTB = HALF * BK * 2  , STAGE_BYTES = 8 * HTB, NXCD = 8, WGM = 8;

__host__ __device__ __forceinline__ int lds_byte(int r, int c) { const int st = (r >> 4) * 2 + (c >> 5), rr = r & 15, cc = c & 31, ob = rr * 64 + cc * 2; return st * 1024 + (ob ^ (((ob >> 9) & 1) << 5)); }
__host__ __device__ __forceinline__ void stage_rc(int b, int& R, int& C) { const int st = b / 1024, sb = b % 1024, swz = sb ^ (((sb >> 9) & 1) << 5); R = (st >> 1) * 16 + swz / 64; C = (st & 1) * 32 + (swz % 64) / 2; }
__host__ __device__ __forceinline__ int perm32(int rho) { const int n = rho >> 4, i = rho & 15; return 8 * (i >> 2) + 4 * n + (i & 3); }

struct Unit { int pm, pn; };
struct Gemm { const bf16_t* A; const bf16_t* Bt; int M, N, K; };

struct StaticOrder {
    int nM, nN, nwg, G, c;
    __host__ __device__ void init(int M, int N, int G_, int c_) { nM = M / BM; nN = N / BM; nwg = nM * nN; G = G_; c = c_; }
    __host__ __device__ bool next(int i, Unit& u) const {
        const long L = (long)i * G + c; if (L >= nwg) return false;
        int wgid = (int)L; { const int q = nwg / NXCD, r = nwg % NXCD, xcd = wgid % NXCD, off = wgid / NXCD; wgid = (xcd < r ? xcd * (q + 1) : r * (q + 1) + (xcd - r) * q) + off; }
        const int nig = WGM * nN, gid = wgid / nig, fm = gid * WGM, gsz = (nM - fm) < WGM ? (nM - fm) : WGM;
        u.pm = fm + ((wgid % nig) % gsz); u.pn = (wgid % nig) / gsz; return true;
    }
    __device__ __forceinline__ void a_ready(const Unit&) const {}
    __device__ __forceinline__ void done(const Unit&) const {}
};

typedef unsigned u32x2 __attribute__((ext_vector_type(2)));
typedef float f32x2_t __attribute__((ext_vector_type(2))); typedef __bf16 bf16x2_t __attribute__((ext_vector_type(2)));
__device__ __forceinline__ unsigned cvt_pk_bf16(float lo, float hi) { f32x2_t v = {lo, hi}; bf16x2_t b = __builtin_convertvector(v, bf16x2_t); return __builtin_bit_cast(unsigned, b); }
__device__ __forceinline__ float row_scale16(const float* ss, int row, float inv_n) {
    const f32x4* p = (const f32x4*)(ss + (size_t)row * 16);
    const f32x4 a = p[0], b = p[1], c = p[2], d = p[3];
    const float s = (((a[0] + a[1]) + (a[2] + a[3])) + ((b[0] + b[1]) + (b[2] + b[3]))) + (((c[0] + c[1]) + (c[2] + c[3])) + ((d[0] + d[1]) + (d[2] + d[3])));
    return __builtin_amdgcn_rsqf(s * inv_n + 1e-6f);
}
__device__ __forceinline__ void row_scales8(const float* ss, int row0, int fq, float inv_n, float (&rs)[8]) {
    f32x4 v[8];
#pragma unroll
    for (int i = 0; i < 8; ++i) v[i] = *(const f32x4*)(ss + (size_t)(row0 + (i >> 2) * HALF + (i & 3) * 16) * 16 + 4 * fq);
#pragma unroll
    for (int i = 0; i < 8; ++i) { float s = (v[i][0] + v[i][1]) + (v[i][2] + v[i][3]); s = xadd<16>(s); s = xadd32(s); rs[i] = __builtin_amdgcn_rsqf(s * inv_n + 1e-6f); }
    asm volatile("" ::: "memory");
}
struct EpiProj {
    static constexpr bool PERM = true, AFTER_DRAIN = false;
    bf16_t* O; int ldc; const float* ss; float* AB; int ab_pn;
    __device__ __forceinline__ void operator()(const f32x4 (&acc)[2][2][4][2], const Unit& u, int wr, int wc, int fr, int fq) const {
        const int row0 = u.pm * BM + wr * 64 + fr, col0 = u.pn * BM + wc * 32 + 8 * fq;
        const bool abt = (u.pn == ab_pn) && (wc == 0) && (fq == 0);
        float rsv[8]; row_scales8(ss, row0, fq, 1.0f / 1024.0f, rsv);
#pragma unroll
        for (int ai = 0; ai < 2; ++ai)
#pragma unroll
            for (int m = 0; m < 4; ++m) { const int row = row0 + ai * HALF + m * 16; const float rs = rsv[ai * 4 + m];
                bf16_t* rowp = O + (size_t)row * ldc + col0;
#pragma unroll
                for (int bj = 0; bj < 2; ++bj) { const f32x4 v0 = acc[ai][bj][m][0] * rs, v1 = acc[ai][bj][m][1] * rs;
                    u32x4 w; w.x = cvt_pk_bf16(v0[0], v0[1]); w.y = cvt_pk_bf16(v0[2], v0[3]); w.z = cvt_pk_bf16(v1[0], v1[1]); w.w = cvt_pk_bf16(v1[2], v1[3]);
                    *(u32x4*)(rowp + bj * HALF) = w;
                    if (bj == 0 && abt) { *(f32x4*)(AB + (size_t)row * 8) = v0; *(f32x4*)(AB + (size_t)row * 8 + 4) = v1; } }
                if (m & 1) asm volatile("" ::: "memory"); }
    }
};
struct EpiResid {
    static constexpr bool PERM = true, AFTER_DRAIN = false;
    const float* Hin; bf16_t* HB; float* Y; float* ss;
    __device__ __forceinline__ void operator()(const f32x4 (&acc)[2][2][4][2], const Unit& u, int wr, int wc, int fr, int fq) const {
        const int row0 = u.pm * BM + wr * 64 + fr, col0 = u.pn * BM + wc * 32 + 8 * fq;
#pragma unroll
        for (int ai = 0; ai < 2; ++ai)
#pragma unroll
            for (int m = 0; m < 4; ++m) { const int row = row0 + ai * HALF + m * 16; const size_t off = (size_t)row * 1024 + col0; float q = 0.f;
#pragma unroll
                for (int bj = 0; bj < 2; ++bj) { const size_t o = off + bj * HALF; f32x4 h0, h1;
                    if (Hin) { h0 = *(const f32x4*)(Hin + o); h1 = *(const f32x4*)(Hin + o + 4); }
                    else { const u32x4 p = *(const u32x4*)(HB + o);
                        h0 = (f32x4){__uint_as_float(p.x << 16), __uint_as_float(p.x & 0xffff0000u), __uint_as_float(p.y << 16), __uint_as_float(p.y & 0xffff0000u)};
                        h1 = (f32x4){__uint_as_float(p.z << 16), __uint_as_float(p.z & 0xffff0000u), __uint_as_float(p.w << 16), __uint_as_float(p.w & 0xffff0000u)}; }
                    h0 = h0 + acc[ai][bj][m][0]; h1 = h1 + acc[ai][bj][m][1];
                    u32x4 w; w.x = cvt_pk_bf16(h0[0], h0[1]); w.y = cvt_pk_bf16(h0[2], h0[3]); w.z = cvt_pk_bf16(h1[0], h1[1]); w.w = cvt_pk_bf16(h1[2], h1[3]); *(u32x4*)(HB + o) = w;
                    if (Y) { *(f32x4*)(Y + o) = h0; *(f32x4*)(Y + o + 4) = h1; }
                    q += ((h0[0] * h0[0] + h0[1] * h0[1]) + (h0[2] * h0[2] + h0[3] * h0[3])) + ((h1[0] * h1[0] + h1[1] * h1[1]) + (h1[2] * h1[2] + h1[3] * h1[3])); }
                q = xadd<16>(q); q = xadd32(q);
                if (fq == 0) ss[(size_t)row * 16 + u.pn * 4 + wc] = q;
                if (m == 3) asm volatile("" ::: "memory"); }
    }
};
struct EpiQ {
    static constexpr bool PERM = true, AFTER_DRAIN = false;
    bf16_t* O; const float* ss; float* qss;
    __device__ __forceinline__ void operator()(const f32x4 (&acc)[2][2][4][2], const Unit& u, int wr, int wc, int fr, int fq) const {
        const int row0 = u.pm * BM + wr * 64 + fr, col0 = u.pn * BM + wc * 32 + 8 * fq;
        float rsv[8]; row_scales8(ss, row0, fq, 1.0f / 1024.0f, rsv);
#pragma unroll
        for (int ai = 0; ai < 2; ++ai)
#pragma unroll
            for (int m = 0; m < 4; ++m) { const int row = row0 + ai * HALF + m * 16; const float rs = rsv[ai * 4 + m];
                bf16_t* rowp = O + (size_t)row * 1024 + col0; float q = 0.f;
#pragma unroll
                for (int bj = 0; bj < 2; ++bj) { const f32x4 v0 = acc[ai][bj][m][0] * rs, v1 = acc[ai][bj][m][1] * rs;
                    u32x4 w; w.x = cvt_pk_bf16(v0[0], v0[1]); w.y = cvt_pk_bf16(v0[2], v0[3]); w.z = cvt_pk_bf16(v1[0], v1[1]); w.w = cvt_pk_bf16(v1[2], v1[3]);
                    *(u32x4*)(rowp + bj * HALF) = w;
                    q += ((v0[0] * v0[0] + v0[1] * v0[1]) + (v0[2] * v0[2] + v0[3] * v0[3])) + ((v1[0] * v1[0] + v1[1] * v1[1]) + (v1[2] * v1[2] + v1[3] * v1[3])); }
                q = xadd<16>(q); q = xadd32(q);
                if (fq == 0) qss[(size_t)row * 16 + u.pn * 4 + wc] = q;
                if (m & 1) asm volatile("" ::: "memory"); }
    }
};
struct EpiUp {
    static constexpr bool PERM = true, AFTER_DRAIN = false;
    bf16_t* G; bf16_t* U; const float* ss; const float* wf; float* pst; float* sst;
    __device__ __forceinline__ void operator()(const f32x4 (&acc)[2][2][4][2], const Unit& u, int wr, int wc, int fr, int fq) const {
        const int row0 = u.pm * BM + wr * 64 + fr, c = u.pn * HALF + wc * 32 + 8 * fq;
        float wg[3][8], wv[3][8];
#pragma unroll
        for (int d = 0; d < 3; ++d) { const f32x4 a0 = *(const f32x4*)(wf + d * 5632 + c), a1 = *(const f32x4*)(wf + d * 5632 + c + 4), b0 = *(const f32x4*)(wf + d * 5632 + 2816 + c), b1 = *(const f32x4*)(wf + d * 5632 + 2816 + c + 4);
#pragma unroll
            for (int j = 0; j < 4; ++j) { wg[d][j] = a0[j]; wg[d][4 + j] = a1[j]; wv[d][j] = b0[j]; wv[d][4 + j] = b1[j]; } }
        float pg[8], pv[8];
#pragma unroll
        for (int j = 0; j < 8; ++j) { pg[j] = 0.f; pv[j] = 0.f; }
#pragma unroll
        for (int ai = 0; ai < 2; ++ai)
#pragma unroll
            for (int m = 0; m < 4; ++m) { const int row = row0 + ai * HALF + m * 16; const float rs = row_scale16(ss, row, 1.0f / 1024.0f);
                float ug[8], uv[8];
#pragma unroll
                for (int j = 0; j < 4; ++j) { ug[j] = acc[ai][0][m][0][j] * rs; ug[4 + j] = acc[ai][0][m][1][j] * rs; uv[j] = acc[ai][1][m][0][j] * rs; uv[4 + j] = acc[ai][1][m][1][j] * rs; }
                const bool smp_ = (u.pm == 64);
                if ((fr < 2 && (m == 0 || smp_)) || (fr >= 14 && (m == 3 || smp_))) { bf16_t* up = U + (size_t)row * 5632 + c;
                    u32x4 w; w.x = cvt_pk_bf16(ug[0], ug[1]); w.y = cvt_pk_bf16(ug[2], ug[3]); w.z = cvt_pk_bf16(ug[4], ug[5]); w.w = cvt_pk_bf16(ug[6], ug[7]); *(u32x4*)up = w;
                    w.x = cvt_pk_bf16(uv[0], uv[1]); w.y = cvt_pk_bf16(uv[2], uv[3]); w.z = cvt_pk_bf16(uv[4], uv[5]); w.w = cvt_pk_bf16(uv[6], uv[7]); *(u32x4*)(up + 2816) = w;
                    float* st = nullptr;
                    if (fr >= 14) { if (u.pm == 64) st = sst + ((size_t)((row - 16384) >> 4) * 2 + (fr - 14)) * 5632 + c;
                                    else if ((row & 8191) >= 8190) st = pst + ((size_t)(row >> 13) * 2 + (fr - 14)) * 5632 + c; }
                    if (st) { *(f32x4*)st = (f32x4){ug[0], ug[1], ug[2], ug[3]}; *(f32x4*)(st + 4) = (f32x4){ug[4], ug[5], ug[6], ug[7]};
                              *(f32x4*)(st + 2816) = (f32x4){uv[0], uv[1], uv[2], uv[3]}; *(f32x4*)(st + 2820) = (f32x4){uv[4], uv[5], uv[6], uv[7]}; } }
                float o[8];
#pragma unroll
                for (int j = 0; j < 8; ++j) {
                    const float zg1 = (fr == 15) ? pg[j] : ug[j], zg2 = (fr >= 14) ? pg[j] : ug[j], zv1 = (fr == 15) ? pv[j] : uv[j], zv2 = (fr >= 14) ? pv[j] : uv[j];
                    const float g1 = __int_as_float(__builtin_amdgcn_update_dpp(0, __float_as_int(zg1), 0x121, 0xf, 0xf, true)), g2 = __int_as_float(__builtin_amdgcn_update_dpp(0, __float_as_int(zg2), 0x122, 0xf, 0xf, true));
                    const float v1 = __int_as_float(__builtin_amdgcn_update_dpp(0, __float_as_int(zv1), 0x121, 0xf, 0xf, true)), v2 = __int_as_float(__builtin_amdgcn_update_dpp(0, __float_as_int(zv2), 0x122, 0xf, 0xf, true));
                    const float yg = (wg[0][j] * g2 + wg[1][j] * g1) + wg[2][j] * ug[j], yv = (wv[0][j] * v2 + wv[1][j] * v1) + wv[2][j] * uv[j];
                    o[j] = (yg * __builtin_amdgcn_rcpf(1.0f + __expf(-yg))) * yv; }
                if (fr >= 2 || (m > 0 && !smp_)) { u32x4 w; w.x = cvt_pk_bf16(o[0], o[1]); w.y = cvt_pk_bf16(o[2], o[3]); w.z = cvt_pk_bf16(o[4], o[5]); w.w = cvt_pk_bf16(o[6], o[7]); *(u32x4*)(G + (size_t)row * 2816 + c) = w; }
#pragma unroll
                for (int j = 0; j < 8; ++j) { pg[j] = ug[j]; pv[j] = uv[j]; }
                if (m == 3) asm volatile("" ::: "memory"); }
    }
};
struct EpiMemKV {
    static constexpr bool PERM = false, AFTER_DRAIN = false;
    float* outK; float* outV; const float* rm; float* kss;
    __device__ __forceinline__ void operator()(const f32x4 (&acc)[2][2][4][2], const Unit& u, int wr, int wc, int fr, int fq) const {
        const int row0 = u.pm * BM + wr * 64 + fr, l = u.pn >> 3, j = u.pn & 7, col0 = (j & 3) * 256 + wc * 32 + 4 * fq;
        float* dst = (j < 4) ? outK : outV;
#pragma unroll
        for (int ai = 0; ai < 2; ++ai)
#pragma unroll
            for (int m = 0; m < 4; ++m) { const int row = row0 + ai * HALF + m * 16; const float rs = rm[row]; const size_t off = ((size_t)l * 512 + row) * 1024 + col0; float q = 0.f;
#pragma unroll
                for (int bj = 0; bj < 2; ++bj)
#pragma unroll
                    for (int n = 0; n < 2; ++n) { const f32x4 v = acc[ai][bj][m][n] * rs; *(f32x4*)(dst + off + bj * HALF + n * 16) = v;
                        q += (v[0] * v[0] + v[1] * v[1]) + (v[2] * v[2] + v[3] * v[3]); }
                q = xadd<16>(q); q = xadd32(q);
                if (j < 4 && fq == 0) kss[((size_t)l * 512 + row) * 16 + j * 4 + wc] = q; }
    }
};

template <class Epi, class Sched, bool ALIGN_EPI = false, bool SP2 = false>
__device__ __forceinline__ void gemm_phase(PG8_LAS unsigned char* lds, const Gemm g, const Sched& S, const Epi& E) {
    int tid_ = threadIdx.x; asm volatile("" : "+v"(tid_));
    const int tid = tid_, wid = __builtin_amdgcn_readfirstlane(tid >> 6), lane = tid & 63, wr = wid >> 2, wc = wid & 3, fr = lane & 15, fq = lane >> 4;
    const int K = g.K, nt = K / BK;
    unsigned voffA[2], voffB[2];
#pragma unroll
    for (int i = 0; i < 2; ++i) { int R, C; stage_rc(tid * 16 + i * 8192, R, C); const int Rb = Epi::PERM ? ((R & ~31) + perm32(R & 31)) : R;
        voffA[i] = (unsigned)(R * K + C) * 2u; voffB[i] = (unsigned)(Rb * K + C) * 2u; }
    const size_t kstep = (size_t)(BK * 2);
    const size_t hstep = (size_t)HALF * K * 2;
    const size_t tstep = 2 * hstep;
    const unsigned ldsw = (unsigned)wid * 1024u;
    const int aoff = lds_byte(wr * 64 + fr, fq * 8), boff = lds_byte(wc * 32 + fr, fq * 8);
#define PG8_SA(b, h) (((b) * 2 + (h)) * HTB)
#define PG8_SB(b, h) ((4 + (b) * 2 + (h)) * HTB)
#define PG8_STAGE(bufoff, gbase, voff) do { _Pragma("unroll") for (int _i = 0; _i < 2; ++_i) \
        __builtin_amdgcn_global_load_lds((const unsigned*)((const char*)(gbase) + (voff)[_i]), (PG8_LAS unsigned*)(lds + (bufoff) + ldsw + _i * 8192), 16, 0, 0); } while (0)
#define PG8_LDA(dst, b, h) do { _Pragma("unroll") for (int m = 0; m < 4; ++m) _Pragma("unroll") for (int k = 0; k < 2; ++k) dst[m][k] = *(const PG8_LAS bf16x8*)(lds + PG8_SA(b, h) + aoff + m * 2048 + k * 1024); } while (0)
#define PG8_LDB(dst, b, h) do { _Pragma("unroll") for (int n = 0; n < 2; ++n) _Pragma("unroll") for (int k = 0; k < 2; ++k) dst[n][k] = *(const PG8_LAS bf16x8*)(lds + PG8_SB(b, h) + boff + n * 2048 + k * 1024); } while (0)
#define PG8_MMA(ai, bj, At, Bt) do { __builtin_amdgcn_s_setprio(1); _Pragma("unroll") for (int m = 0; m < 4; ++m) _Pragma("unroll") for (int n = 0; n < 2; ++n) _Pragma("unroll") for (int k = 0; k < 2; ++k) \
        acc[ai][bj][m][n] = __builtin_amdgcn_mfma_f32_16x16x32_bf16(Bt[n][k], At[m][k], acc[ai][bj][m][n], 0, 0, 0); __builtin_amdgcn_s_setprio(0); } while (0)
#define PG8_WAIT_V(n) asm volatile("s_waitcnt vmcnt(" #n ")" ::: "memory")
#define PG8_WAIT_L(n) asm volatile("s_waitcnt lgkmcnt(" #n ")" ::: "memory")
#define PG8_BAR __builtin_amdgcn_s_barrier()
#define PG8_SCHED __builtin_amdgcn_sched_barrier(0)
    Unit cur, nxt; int ui = 0;
    if (!S.next(0, cur)) return;
    f32x4 acc[2][2][4][2];
#pragma unroll
    for (int a = 0; a < 2; ++a)
#pragma unroll
        for (int b = 0; b < 2; ++b)
#pragma unroll
            for (int m = 0; m < 4; ++m)
#pragma unroll
                for (int n = 0; n < 2; ++n) acc[a][b][m][n] = (f32x4){0.f, 0.f, 0.f, 0.f};
    bf16x8 At[4][2], B0[2][2], B1[2][2];
    const char* cA = (const char*)g.A + (size_t)cur.pm * tstep; const char* cB = (const char*)g.Bt + (size_t)cur.pn * tstep;
    S.a_ready(cur);
    if constexpr (SP2) {
        PG8_STAGE(PG8_SB(0, 0), cB, voffB); PG8_STAGE(PG8_SB(0, 1), cB + hstep, voffB); PG8_STAGE(PG8_SA(0, 0), cA, voffA); PG8_STAGE(PG8_SA(0, 1), cA + hstep, voffA);
        if (wr == 1) PG8_BAR;
        PG8_WAIT_V(2); PG8_BAR;
        PG8_STAGE(PG8_SB(1, 0), cB + kstep, voffB); PG8_STAGE(PG8_SA(1, 0), cA + kstep, voffA); PG8_STAGE(PG8_SB(1, 1), cB + hstep + kstep, voffB);
        PG8_WAIT_V(6); PG8_BAR;
    } else {
        PG8_STAGE(PG8_SB(0, 0), cB, voffB); PG8_STAGE(PG8_SA(0, 0), cA, voffA); PG8_STAGE(PG8_SB(0, 1), cB + hstep, voffB); PG8_STAGE(PG8_SA(0, 1), cA + hstep, voffA);
        if (wr == 1) PG8_BAR;
        PG8_WAIT_V(4); PG8_BAR;
        PG8_STAGE(PG8_SB(1, 0), cB + kstep, voffB); PG8_STAGE(PG8_SA(1, 0), cA + kstep, voffA); PG8_STAGE(PG8_SB(1, 1), cB + hstep + kstep, voffB);
        PG8_WAIT_V(6); PG8_BAR;
    }
    for (;;) {
        const bool has_next = S.next(ui + 1, nxt);
        const char* nA = has_next ? (const char*)g.A + (size_t)nxt.pm * tstep : cA; const char* nB = has_next ? (const char*)g.Bt + (size_t)nxt.pn * tstep : cB;
        for (int t = 0; t < nt; t += 2) {
            const bool last = (t == nt - 2);
            const char* a1 = cA + (size_t)(t + 1) * kstep;
            const char* a2 = last ? nA : cA + (size_t)(t + 2) * kstep; const char* b2 = last ? nB : cB + (size_t)(t + 2) * kstep;
            const char* a3 = a2 + kstep; const char* b3 = b2 + kstep;
            if (last && has_next) S.a_ready(nxt);
            if constexpr (SP2) {
            PG8_LDB(B0, 0, 0); PG8_LDB(B1, 0, 1); PG8_SCHED; PG8_LDA(At, 0, 0); PG8_STAGE(PG8_SA(1, 1), a1 + hstep, voffA);
            PG8_WAIT_V(8); PG8_WAIT_L(0); PG8_BAR; PG8_MMA(0, 0, At, B0); PG8_MMA(0, 1, At, B1); PG8_BAR; PG8_SCHED;
            PG8_LDA(At, 0, 1); PG8_STAGE(PG8_SB(0, 0), b2, voffB); PG8_STAGE(PG8_SB(0, 1), b2 + hstep, voffB); PG8_STAGE(PG8_SA(0, 0), a2, voffA);
            PG8_WAIT_V(8); PG8_WAIT_L(0); PG8_BAR; PG8_MMA(1, 0, At, B0); PG8_MMA(1, 1, At, B1); PG8_BAR; PG8_SCHED;
            PG8_LDB(B0, 1, 0); PG8_LDB(B1, 1, 1); PG8_SCHED; PG8_LDA(At, 1, 0); PG8_STAGE(PG8_SA(0, 1), a2 + hstep, voffA);
            PG8_WAIT_V(8); PG8_WAIT_L(0); PG8_BAR; PG8_MMA(0, 0, At, B0); PG8_MMA(0, 1, At, B1); PG8_BAR; PG8_SCHED;
            PG8_LDA(At, 1, 1); PG8_STAGE(PG8_SB(1, 0), b3, voffB); PG8_STAGE(PG8_SB(1, 1), b3 + hstep, voffB); PG8_STAGE(PG8_SA(1, 0), a3, voffA);
            PG8_WAIT_V(8); PG8_WAIT_L(0); PG8_BAR; PG8_MMA(1, 0, At, B0); PG8_MMA(1, 1, At, B1); PG8_BAR; PG8_SCHED;
            } else {
            PG8_LDB(B0, 0, 0); PG8_SCHED; PG8_LDA(At, 0, 0); PG8_STAGE(PG8_SA(1, 1), a1 + hstep, voffA);
            PG8_WAIT_L(8); PG8_BAR; PG8_WAIT_L(0); PG8_MMA(0, 0, At, B0); PG8_BAR; PG8_SCHED;
            PG8_LDB(B1, 0, 1); PG8_STAGE(PG8_SB(0, 0), b2, voffB);
            PG8_BAR; PG8_WAIT_L(0); PG8_MMA(0, 1, At, B1); PG8_BAR;
            PG8_LDA(At, 0, 1); PG8_STAGE(PG8_SA(0, 0), a2, voffA);
            PG8_BAR; PG8_WAIT_L(0); PG8_MMA(1, 0, At, B0); PG8_BAR; PG8_SCHED;
            PG8_STAGE(PG8_SB(0, 1), b2 + hstep, voffB);
            PG8_WAIT_V(6); PG8_BAR; PG8_MMA(1, 1, At, B1); PG8_BAR;
            PG8_LDB(B0, 1, 0); PG8_SCHED; PG8_LDA(At, 1, 0); PG8_STAGE(PG8_SA(0, 1), a2 + hstep, voffA);
            PG8_WAIT_L(8); PG8_BAR; PG8_WAIT_L(0); PG8_MMA(0, 0, At, B0); PG8_BAR; PG8_SCHED;
            PG8_LDB(B1, 1, 1); PG8_STAGE(PG8_SB(1, 0), b3, voffB);
            PG8_BAR; PG8_WAIT_L(0); PG8_MMA(0, 1, At, B1); PG8_BAR;
            PG8_LDA(At, 1, 1); PG8_STAGE(PG8_SA(1, 0), a3, voffA);
            PG8_BAR; PG8_WAIT_L(0); PG8_MMA(1, 0, At, B0); PG8_BAR; PG8_SCHED;
            PG8_STAGE(PG8_SB(1, 1), b3 + hstep, voffB);
            PG8_WAIT_V(6); PG8_BAR; PG8_MMA(1, 1, At, B1); PG8_BAR;
            }
        }
        if constexpr (ALIGN_EPI) { if (wr == 0) PG8_BAR; }
        if constexpr (!Epi::AFTER_DRAIN) { E(acc, cur, wr, wc, fr, fq); S.done(cur); }
        if (!has_next) break;
#pragma unroll
        for (int a = 0; a < 2; ++a)
#pragma unroll
            for (int b = 0; b < 2; ++b)
#pragma unroll
                for (int m = 0; m < 4; ++m)
#pragma unroll
                    for (int n = 0; n < 2; ++n) acc[a][b][m][n] = (f32x4){0.f, 0.f, 0.f, 0.f};
        cur = nxt; cA = nA; cB = nB; ++ui;
        if constexpr (ALIGN_EPI) { if (wr == 1) PG8_BAR; }
    }
    PG8_WAIT_V(0);
    if constexpr (!ALIGN_EPI) { if (wr == 0) PG8_BAR; }
    PG8_BAR;
    if constexpr (Epi::AFTER_DRAIN) { E.fused(acc, cur, wr, wc, fr, fq, lds, wid, lane); S.done(cur); }
#undef PG8_SA
#undef PG8_SB
#undef PG8_STAGE
#undef PG8_LDA
#undef PG8_LDB
#undef PG8_MMA
#undef PG8_WAIT_V
#undef PG8_WAIT_L
#undef PG8_BAR
#undef PG8_SCHED
}
}
constexpr int NWAVES = 8;
constexpr int DM = 1024, BATCH = 2, SEQ = 8192, DEPTH = 4, DECB = 16, DECS = 16;
constexpr int MP = BATCH * SEQ, MS = DECB * DECS, M = MP + MS;
constexpr int NPROJ = 3584, DFF = 2816, NUP = 2 * DFF;
constexpr int PC_Z = 1536, PC_SQ = 2048, PC_SK = 2304, PC_SV = 2432, PC_SCB = 2560, PC_SCC = 2816, PC_SCH = 3072, PC_AB = 3328;
constexpr float EPS = 1e-6f;
enum { I_XP = 0, I_XS, I_MEM, I_SGDN, I_SGCONV, I_CSK, I_CSV, I_SSC, I_CMK, I_CMV, I_SFFN, I_NMIX, I_WIN, I_WGCONV, I_ALOG, I_DTB, I_GNG, I_SQG, I_SKG, I_SINK,
       I_WSC, I_WO, I_NMEM, I_NMIN, I_WMQ, I_WMK, I_WMV, I_MQG, I_MKG, I_WMO, I_NFFN, I_WUP, I_WFC, I_WDN, N_IN };
constexpr size_t O_Y = 0, O_PSG = 17039360, O_PGC = 17563648, O_PSK = 17600512, O_PSV = 17731584, O_PSC = 17862656, O_PMK = 17866752, O_PMV = 19963904, O_PFC = 22061056,
                 O_SSG = 22151168, O_SGC = 26345472, O_SSK = 26640384, O_SSV = 26771456, O_SSC = 26902528, O_SFC = 26935296, O_END = 27656192;

constexpr size_t MiB = 1u << 20;
constexpr size_t WS_CTL = 0, CTL_ZERO_BYTES = 1 * MiB;
constexpr size_t WS_WB0 = 2 * MiB, WS_WB1 = 32 * MiB;
constexpr size_t WB_WIN = 0, WB_WO = 7 * MiB, WB_WMQ = 9 * MiB, WB_WMO = 11 * MiB, WB_WUP = 13 * MiB, WB_WDN = 24 * MiB;
constexpr size_t WS_HB = 62 * MiB;
constexpr size_t WS_BIG = 96 * MiB;
constexpr size_t WS_WMKV = WS_BIG + 120 * MiB;
constexpr size_t WS_GREG = 275 * MiB;
constexpr size_t WS_MIX = WS_GREG, WS_QATT = WS_GREG + 33 * MiB, WS_OBUF = WS_GREG + 66 * MiB;
constexpr size_t WS_GDN = 365 * MiB;
constexpr int NITEM = 1088;
constexpr size_t WS_WKN = WS_GDN, WS_QG = WS_GDN + 17 * MiB, WS_KDT = WS_GDN + 34 * MiB, WS_U0L = WS_GDN + 51 * MiB, WS_QKM = WS_GDN + 68 * MiB, WS_GL = WS_GDN + 77 * MiB;
constexpr size_t WS_ATT = WS_GDN;
constexpr size_t WS_MEMK = 443 * MiB, WS_MEMVT = 447 * MiB;
constexpr size_t WS_MB = 451 * MiB;
constexpr size_t WS_SS = 452 * MiB, WS_QSS = 454 * MiB;
constexpr size_t WS_AB = 456 * MiB;
constexpr size_t WS_KSS = 457 * MiB;
constexpr size_t WS_RM = WS_KSS + 256 * 1024;
constexpr size_t WS_END = 458 * MiB;
static_assert((size_t)NITEM * 16384 <= 17 * MiB && (size_t)NITEM * 8192 <= 9 * MiB, "gdn operand buffers");
static_assert((size_t)M * NUP * 2 <= WS_GREG - WS_BIG && (size_t)M * DFF * 2 <= WS_GDN - WS_GREG && (size_t)M * NPROJ * 2 <= 120 * MiB, "ws map");
constexpr int CW_BAR = 4096;

constexpr int RING_OFF = 0, RING_BYTES = 131072;
constexpr int LDSCTL_OFF = 143360, MISC_OFF = LDSCTL_OFF + 320;
constexpr int LDS_BYTES = 147456;

#define GAS __attribute__((address_space(1)))
#define LAS __attribute__((address_space(3)))
typedef unsigned short bf16;
typedef unsigned v4u __attribute__((ext_vector_type(4)));
typedef unsigned v2u __attribute__((ext_vector_type(2)));
typedef float f32x4 __attribute__((ext_vector_type(4)));
typedef short bf16x8 __attribute__((ext_vector_type(8)));
#define LDS_WAIT() asm volatile("s_waitcnt lgkmcnt(0)" ::: "memory")
#define VM_WAIT() asm volatile("s_waitcnt vmcnt(0)" ::: "memory")
__device__ __forceinline__ unsigned pk2(float lo, float hi) { return pg8::cvt_pk_bf16(lo, hi); }
__device__ __forceinline__ bf16 f2bf(float f) { return (bf16)(pk2(f, 0.f) & 0xffffu); }
__device__ __forceinline__ float bf2f(bf16 b) { return __uint_as_float((unsigned)b << 16); }
__device__ __forceinline__ float bflo(unsigned w) { return __uint_as_float(w << 16); }
__device__ __forceinline__ float bfhi(unsigned w) { return __uint_as_float(w & 0xffff0000u); }
__device__ __forceinline__ float silu_f(float y) { return y * __builtin_amdgcn_rcpf(1.0f + __expf(-y)); }
__device__ __forceinline__ bf16x8 mk8(unsigned a, unsigned b, unsigned c, unsigned d) { v4u t; t.x = a; t.y = b; t.z = c; t.w = d; return __builtin_bit_cast(bf16x8, t); }
template <class T> __device__ __forceinline__ T* launder_g(T* p) { unsigned long long v = (unsigned long long)p; asm volatile("" : "+v"(v)); return (T*)(GAS T*)v; }
typedef unsigned long long u64;
__device__ __forceinline__ void st_wt16(void* p, bf16x8 v) {
    const v4u t = __builtin_bit_cast(v4u, v);
    asm volatile("global_store_dwordx4 %0, %1, off sc1\n\ts_nop 1" :: "v"((GAS unsigned char*)p), "v"(t) : "memory");
}
__device__ __forceinline__ f32x4 mfma16(bf16x8 a, bf16x8 b, f32x4 c) { return __builtin_amdgcn_mfma_f32_16x16x32_bf16(a, b, c, 0, 0, 0); }
struct Args { const float* in[N_IN]; float* out; unsigned char* ws; int ph_lo, ph_hi; };
#define FA Frame& F, const Args& A
#define CAS __attribute__((address_space(4)))
#define INP(k) (*(const float* const CAS*)(F.kp + 8 * (k)))
#define XB_TMO      128
#define XB_XCNT(j)  (256  + 64 * (j))
#define XB_XSUB(j)  (1280 + 64 * (j))
#define XB_XGEN(j)  (2304 + 64 * (j))
#define XB_TOP      3328
#define XB_TOPGEN   3392
#define XCD_BAR_WORDS 3456
#define XB_SPIN_CAP (1u << 21)

__device__ __forceinline__ unsigned xb_ld(unsigned* p)              { return __hip_atomic_load(p, __ATOMIC_RELAXED, __HIP_MEMORY_SCOPE_AGENT); }
__device__ __forceinline__ unsigned xb_add(unsigned* p, unsigned v) { return __hip_atomic_fetch_add(p, v, __ATOMIC_RELAXED, __HIP_MEMORY_SCOPE_AGENT); }
__device__ __forceinline__ unsigned xb_xcc_id() { return (unsigned)__builtin_amdgcn_s_getreg((3 << 11) | 20) & 0xFu; }
#define XB_SPIN(cond, bar) do { unsigned _sp = 0; while (cond) { __builtin_amdgcn_s_sleep(1); \
    if ((++_sp & 255u) == 0u) { if (xb_ld(&(bar)[XB_TMO])) break; if (_sp > XB_SPIN_CAP) { atomicAdd(&(bar)[XB_TMO], 1u); break; } } } } while (0)

struct XcdBarrier {
    unsigned* bar; unsigned x;
    volatile LAS unsigned* st;
};

__device__ __forceinline__ XcdBarrier xcd_barrier_post(unsigned* bar, volatile LAS unsigned* st) {
    XcdBarrier b; b.bar = bar; b.x = xb_xcc_id(); b.st = st;
    if (threadIdx.x == 0) (void)xb_add(&bar[XB_XCNT(b.x)], 1u);
    return b;
}
__device__ __forceinline__ void xcd_barrier_complete(unsigned* bar, unsigned x, unsigned& nloc, unsigned& nx) {
    const unsigned G = gridDim.x * gridDim.y * gridDim.z;
    unsigned sum, cnt, mine, sp = 0u;
    for (;;) {
        sum = 0u; cnt = 0u; mine = 0u;
#pragma unroll
        for (unsigned j = 0; j < 16; ++j) { const unsigned c = xb_ld(&bar[XB_XCNT(j)]); sum += c; cnt += (c > 0u) ? 1u : 0u; mine = (j == x) ? c : mine; }
        if (sum == G) break;
        __builtin_amdgcn_s_sleep(1);
        if ((++sp & 255u) == 0u) { if (xb_ld(&bar[XB_TMO])) break; if (sp > XB_SPIN_CAP) { atomicAdd(&bar[XB_TMO], 1u); break; } }
    }
    nloc = mine > 0u ? mine : 1u; nx = cnt > 0u ? cnt : 1u;
}

__device__ __forceinline__ void xcd_barrier(const XcdBarrier& b) {
    asm volatile("s_waitcnt vmcnt(0)" ::: "memory");
    __syncthreads();
    if (threadIdx.x == 0) {
        unsigned* bar = b.bar;
        __builtin_amdgcn_s_waitcnt(0);
        unsigned nloc = b.st[0], nx = b.st[1];
        if (nloc == 0u) { xcd_barrier_complete(bar, b.x, nloc, nx); b.st[0] = nloc; b.st[1] = nx; }
        const unsigned old = xb_add(&bar[XB_XSUB(b.x)], 1u);
        const unsigned gen = old / nloc;
        if (old + 1u == (gen + 1u) * nloc) {
            __builtin_amdgcn_fence(__ATOMIC_RELEASE, "agent");
            asm volatile("s_waitcnt vmcnt(0)" ::: "memory");
            const unsigned og = xb_add(&bar[XB_TOP], 1u);
            const unsigned tg = og / nx;
            if (og + 1u == (tg + 1u) * nx) xb_add(&bar[XB_TOPGEN], 1u);
            else XB_SPIN(xb_ld(&bar[XB_TOPGEN]) == tg, bar);
            __builtin_amdgcn_fence(__ATOMIC_ACQUIRE, "agent");
            xb_add(&bar[XB_XGEN(b.x)], 1u);
            asm volatile("s_waitcnt vmcnt(0)" ::: "memory");
        } else {
            XB_SPIN(xb_ld(&bar[XB_XGEN(b.x)]) == gen, bar);
            __builtin_amdgcn_fence(__ATOMIC_ACQUIRE, "agent");
            asm volatile("s_waitcnt vmcnt(0)" ::: "memory");
        }
    }
    __syncthreads();
}
struct Frame {
    LAS unsigned char* lds;
    volatile LAS unsigned* MISC;
    unsigned* ctl;
    int tid, lane, wave;
    int G, bid;

    float* out; unsigned char* ws;
    const __attribute__((address_space(4))) char* kp;
};

__device__ __forceinline__ float wave_sum(float v) {
    v = xadd<1>(v); v = xadd<2>(v); v = xadd<4>(v); v = xadd<8>(v); v = xadd<16>(v); v = xadd32(v);
    return v;
}
__device__ __forceinline__ unsigned char* wbuf(Frame& F, int l) { return F.ws + ((l & 1) ? WS_WB1 : WS_WB0); }

__device__ __forceinline__ void conv_item(const float* W, int N, int K, bf16* WT, const float* gain, int colmode, int nblk, LAS float* scr, int item, int lane) {
    const int kb = item / nblk, nb = item - kb * nblk, k0 = 64 * kb, n0 = 32 * nb;
    const int nd = n0 + (lane & 31);
    int ns = nd;
    if (colmode == 1) ns = (nd < 2048) ? nd : ((nd < 3328) ? nd + 8 : ((nd < 3336) ? nd - 1280 : -1));
    if (colmode == 2) { const int pn_ = nd >> 8, wi_ = nd & 255; ns = (wi_ < 128) ? (128 * pn_ + wi_) : (2816 + 128 * pn_ + (wi_ - 128)); }
    float wv_[32];
    const float* wp_ = W + (size_t)(k0 + (lane >> 5)) * N + (ns >= 0 ? ns : 0);
#pragma unroll
    for (int i = 0; i < 32; ++i) wv_[i] = (ns >= 0) ? wp_[(size_t)(2 * i) * N] : 0.f;
#pragma unroll
    for (int i = 0; i < 32; ++i) { const int kk = 2 * i + (lane >> 5); float v = wv_[i]; if (gain) v *= gain[k0 + kk]; scr[kk * 33 + (lane & 31)] = v; }
    LDS_WAIT(); asm volatile("" ::: "memory");
    const int c = lane & 7;
#pragma unroll
    for (int j = 0; j < 4; ++j) { const int n = (lane >> 3) + 8 * j; const LAS float* s = scr + (8 * c) * 33 + n;
        v4u o; o.x = pk2(s[0 * 33], s[1 * 33]); o.y = pk2(s[2 * 33], s[3 * 33]); o.z = pk2(s[4 * 33], s[5 * 33]); o.w = pk2(s[6 * 33], s[7 * 33]);
        *(v4u*)(WT + (size_t)(n0 + n) * K + k0 + 8 * c) = o; }
    LDS_WAIT(); asm volatile("" ::: "memory");
}
constexpr int CI_WIN = 16 * 112, CI_SQ = 16 * 32, CI_WUP = 16 * 176, CI_WDN = 44 * 32, CI_LAYER = CI_WIN + 3 * CI_SQ + CI_WUP + CI_WDN;
__device__ __forceinline__ void conv_layer_item(FA, int l, int r, LAS float* scr) {
    unsigned char* wb = wbuf(F, l);
    if (r < CI_WIN) { conv_item(INP(I_WIN) + (size_t)l * 1024 * 3336, 3336, 1024, (bf16*)(wb + WB_WIN), INP(I_NMIX) + l * 1024, 1, 112, scr, r, F.lane); return; } r -= CI_WIN;
    if (r < CI_SQ) { conv_item(INP(I_WO) + (size_t)l * 1024 * 1024, 1024, 1024, (bf16*)(wb + WB_WO), nullptr, 0, 32, scr, r, F.lane); return; } r -= CI_SQ;
    if (r < CI_SQ) { conv_item(INP(I_WMQ) + (size_t)l * 1024 * 1024, 1024, 1024, (bf16*)(wb + WB_WMQ), INP(I_NMEM) + l * 1024, 0, 32, scr, r, F.lane); return; } r -= CI_SQ;
    if (r < CI_SQ) { conv_item(INP(I_WMO) + (size_t)l * 1024 * 1024, 1024, 1024, (bf16*)(wb + WB_WMO), nullptr, 0, 32, scr, r, F.lane); return; } r -= CI_SQ;
    if (r < CI_WUP) { conv_item(INP(I_WUP) + (size_t)l * 1024 * 5632, 5632, 1024, (bf16*)(wb + WB_WUP), INP(I_NFFN) + l * 1024, 2, 176, scr, r, F.lane); return; } r -= CI_WUP;
    conv_item(INP(I_WDN) + (size_t)l * 2816 * 1024, 1024, 2816, (bf16*)(wb + WB_WDN), nullptr, 0, 32, scr, r, F.lane);
}

__device__ __forceinline__ void p_prologue(FA) {
    LAS float* scr = (LAS float*)(F.lds + RING_OFF + F.wave * 16384);
    const int gw = F.bid * NWAVES + F.wave, NGW = F.G * NWAVES;
    for (int it = gw; it < CI_LAYER + 8 * CI_SQ; it += NGW) {
        if (it < CI_LAYER) { conv_layer_item(F, A, 0, it, scr); continue; }
        const int r = it - CI_LAYER, mat = r / CI_SQ, item = r - mat * CI_SQ, l = mat >> 1;
        const float* W = ((mat & 1) ? INP(I_WMV) : INP(I_WMK)) + (size_t)l * 1024 * 1024;
        conv_item(W, 1024, 1024, (bf16*)(F.ws + WS_WMKV) + (size_t)mat * 1024 * 1024, INP(I_NMIN) + l * 1024, 0, 32, scr, item, F.lane);
    }
    bf16* HB = (bf16*)(F.ws + WS_HB); float* SS = (float*)(F.ws + WS_SS);
    for (int m = gw; m < M + 512; m += NGW) {
        const bool ismem = m >= M; const int r = ismem ? m - M : m;
        const float* src = ismem ? INP(I_MEM) + (size_t)r * 1024 : (r < MP ? INP(I_XP) + (size_t)r * 1024 : INP(I_XS) + (size_t)(r - MP) * 1024);
        const f32x4* xr = (const f32x4*)src + F.lane;
        f32x4 v[4]; float s = 0.f;
#pragma unroll
        for (int j = 0; j < 4; ++j) { v[j] = xr[64 * j]; s += (v[j].x * v[j].x + v[j].y * v[j].y) + (v[j].z * v[j].z + v[j].w * v[j].w); }
        s = wave_sum(s);
        bf16* brow = ismem ? (bf16*)(F.ws + WS_MB) + (size_t)r * 1024 : HB + (size_t)r * 1024;
#pragma unroll
        for (int j = 0; j < 4; ++j) { v2u w; w.x = pk2(v[j].x, v[j].y); w.y = pk2(v[j].z, v[j].w); *((v2u*)brow + F.lane + 64 * j) = w;
            }
        if (ismem) { if (F.lane == 0) ((float*)(F.ws + WS_RM))[r] = 1.0f / sqrtf(s * (1.0f / 1024.0f) + EPS); }
        else if (F.lane < 16) SS[(size_t)r * 16 + F.lane] = (F.lane == 0) ? s : 0.f;
    }
}

__device__ __forceinline__ void memkv_fix_row(FA, int t) {
    const int l = t >> 9, row = t & 511, b = row >> 8, key = row & 255, lane = F.lane, head = lane >> 4;
    float* kb = F.out + O_PMK + ((size_t)l * 512 + row) * 1024 + lane * 16;
    const float* vb = F.out + O_PMV + ((size_t)l * 512 + row) * 1024 + lane * 16;
    const float* kss = (const float*)(F.ws + WS_KSS) + ((size_t)l * 512 + row) * 16 + head * 4;
    const f32x4 q = *(const f32x4*)kss;
    const float rk = 1.0f / sqrtf(((q[0] + q[1]) + (q[2] + q[3])) * (1.0f / 256.0f) + EPS);
    const float* g = INP(I_MKG) + l * 256 + (lane & 15) * 16;
    bf16* mk = (bf16*)(F.ws + WS_MEMK) + ((size_t)l * 512 + row) * 1024 + lane * 16;
    const int keyp = (key & ~31) | (((key >> 2) & 3) << 3) | (((key >> 4) & 1) << 2) | (key & 3);
    bf16* mvt = (bf16*)(F.ws + WS_MEMVT) + ((size_t)((l * 2 + b) * 4 + head) * 256 + (lane & 15) * 16) * 256 + keyp;
#pragma unroll
    for (int j = 0; j < 4; ++j) {
        f32x4 k = *(const f32x4*)(kb + 4 * j); const f32x4 gg = *(const f32x4*)(g + 4 * j);
        k = k * rk * gg; *(f32x4*)(kb + 4 * j) = k;
        v2u w; w.x = pk2(k[0], k[1]); w.y = pk2(k[2], k[3]); *(v2u*)(mk + 4 * j) = w;
        const f32x4 v = *(const f32x4*)(vb + 4 * j);
        mvt[(size_t)(4 * j + 0) * 256] = f2bf(v[0]); mvt[(size_t)(4 * j + 1) * 256] = f2bf(v[1]); mvt[(size_t)(4 * j + 2) * 256] = f2bf(v[2]); mvt[(size_t)(4 * j + 3) * 256] = f2bf(v[3]);
    }
}
constexpr int GP_QL = 0, GP_KL = 17408, GP_LM = 34816, GP_XT = 0  , GP_GC = 51456, GP_BETA = 51712, GP_EG = 51968, GP_DG = 52224, GP_RQ = 52480, GP_RK = 52736, GP_SQP = 52992, GP_RHS = 53760, GP_QGT = 119296;
__device__ __forceinline__ void gdn_prep_item(FA, int l, int it, unsigned* prev_ready) {
    const int tid = F.tid, lane = F.lane, wave = F.wave;
    const bool samp = it >= 1024;
    const int h = it & 3, sb = samp ? ((it - 1024) >> 2) : (it >> 9), c = samp ? 0 : ((it >> 2) & 127);
    const int ntok = samp ? 16 : 64;
    const int row0 = samp ? (MP + sb * 16) : (sb * SEQ + c * 64);
    const bf16* PROJ = (const bf16*)(F.ws + WS_BIG);
    LAS bf16* QL = (LAS bf16*)(F.lds + GP_QL); LAS bf16* KL = (LAS bf16*)(F.lds + GP_KL); LAS float* LM = (LAS float*)(F.lds + GP_LM);
    LAS float* GC = (LAS float*)(F.lds + GP_GC); LAS float* BETA = (LAS float*)(F.lds + GP_BETA); LAS float* EG = (LAS float*)(F.lds + GP_EG); LAS float* DG = (LAS float*)(F.lds + GP_DG);
    LAS float* RQ = (LAS float*)(F.lds + GP_RQ); LAS float* RK = (LAS float*)(F.lds + GP_RK); LAS float* SQP = (LAS float*)(F.lds + GP_SQP); LAS float* RHS = (LAS float*)(F.lds + GP_RHS); LAS bf16* QGT = (LAS bf16*)(F.lds + GP_QGT);
    bf16* WKN = (bf16*)(F.ws + WS_WKN) + (size_t)it * 8192; bf16* QG = (bf16*)(F.ws + WS_QG) + (size_t)it * 8192; bf16* KDT = (bf16*)(F.ws + WS_KDT) + (size_t)it * 8192;
    bf16* U0L = (bf16*)(F.ws + WS_U0L) + (size_t)it * 8192; bf16* QKM = (bf16*)(F.ws + WS_QKM) + (size_t)it * 4096; float* GL = (float*)(F.ws + WS_GL);
    const int kind = tid >> 7, ch = tid & 127;
    LAS bf16* XT = (LAS bf16*)(F.lds + GP_XT);
    v4u xr[7];
#pragma unroll
    for (int k = 0; k < 7; ++k) { const int idx = tid + 512 * k, r = idx / 48, sg = idx - r * 48; xr[k] = (v4u){0u, 0u, 0u, 0u};
        if (idx < 67 * 48 && r < 3 + ntok && (r >= 3 || (!samp && c > 0))) xr[k] = *(const v4u*)(PROJ + (size_t)(row0 - 3 + r) * NPROJ + (sg >> 4) * 512 + h * 128 + (sg & 15) * 8); }
    float w0 = 0.f, w1 = 0.f, w2 = 0.f, w3 = 0.f;
    if (kind < 3) { const float* wc = INP(I_WGCONV) + (size_t)l * 4 * 1536 + kind * 512 + h * 128 + ch; w0 = wc[0]; w1 = wc[1536]; w2 = wc[2 * 1536]; w3 = wc[3 * 1536]; }
    if (wave == 6) {
        const int i = lane; float g = 0.f, be = 0.f;
        if (i < ntok) { const float* ab = (const float*)(F.ws + WS_AB) + (size_t)(row0 + i) * 8;
            const float x = ab[h] + INP(I_DTB)[l * 4 + h]; const float ex = __expf(x); const float sp = (x > 20.f) ? x : ((x < -8.f) ? ex : __logf(1.0f + ex));
            g = -__expf(INP(I_ALOG)[l * 4 + h]) * sp; be = 1.0f / (1.0f + __expf(-ab[4 + h])); }
        float gc = g;
#pragma unroll
        for (int o = 1; o < 64; o <<= 1) { EG[i] = gc; LDS_WAIT(); asm volatile("" ::: "memory"); const float t = EG[(i - o) & 63]; LDS_WAIT(); asm volatile("" ::: "memory"); if (i >= o) gc += t; }
        EG[i] = gc; LDS_WAIT(); asm volatile("" ::: "memory");
        const float gtot = EG[63]; LDS_WAIT(); asm volatile("" ::: "memory");
        GC[i] = gc; BETA[i] = be; EG[i] = __expf(gc); DG[i] = __expf(gtot - gc);
        if (lane == 63) __hip_atomic_store(GL + it, __expf(gtot), __ATOMIC_RELAXED, __HIP_MEMORY_SCOPE_AGENT);
    }
#pragma unroll
    for (int k = 0; k < 7; ++k) { const int idx = tid + 512 * k; if (idx < 67 * 48) *(LAS v4u*)(F.lds + GP_XT + idx * 16) = xr[k]; }
    asm volatile("s_waitcnt vmcnt(0)" ::: "memory");
    __syncthreads();
    if (prev_ready && tid == 0) __hip_atomic_store(prev_ready, 1u, __ATOMIC_RELAXED, __HIP_MEMORY_SCOPE_AGENT);
    float val[64];
    if (kind < 3) {
        const int gch = kind * 512 + h * 128 + ch;
        const LAS bf16* xt = XT + kind * 128 + ch;
        float xm3 = bf2f(xt[0]), xm2 = bf2f(xt[384]), xm1 = bf2f(xt[768]);
        if (samp) { const float* st = INP(I_SGCONV) + ((size_t)(l * 16 + sb) * 3) * 1536 + gch; xm3 = st[0]; xm2 = st[1536]; xm1 = st[2 * 1536]; }
#pragma unroll
        for (int i = 0; i < 64; ++i) {
            float x = 0.f, v = 0.f;
            if (i < ntok) { x = bf2f(xt[(i + 3) * 384]); const float y = (w0 * xm3 + w1 * xm2) + (w2 * xm1 + w3 * x); v = silu_f(y); }
            val[i] = v; xm3 = xm2; xm2 = xm1; xm1 = x;
            if (i == 15 && samp) { float* o = F.out + O_SGC + ((size_t)(l * 16 + sb) * 3) * 1536 + gch; o[0] = xm3; o[1536] = xm2; o[2 * 1536] = xm1; }
            if (i == 63 && !samp && c == 127) { float* o = F.out + O_PGC + ((size_t)(l * 2 + sb) * 3) * 1536 + gch; o[0] = xm3; o[1536] = xm2; o[2 * 1536] = xm1; }
        }
        if (kind < 2) {
            LAS float* T = (LAS float*)(F.lds + GP_RHS) + (size_t)(kind * 64) * 132 + ch;
#pragma unroll
            for (int i = 0; i < 64; ++i) T[i * 132] = val[i] * val[i];
        }
    } else {
#pragma unroll
        for (int i = 0; i < 64; ++i) val[i] = 0.f;
    }
    __syncthreads();
    { const int p = tid >> 2, qd = tid & 3;
      const LAS float* T = (const LAS float*)(F.lds + GP_RHS) + (size_t)p * 132 + 32 * qd;
      float s = 0.f;
#pragma unroll
      for (int j = 0; j < 8; ++j) { const f32x4 v = *(const LAS f32x4*)(T + 4 * j); s += (v[0] + v[1]) + (v[2] + v[3]); }
      s = xadd<1>(s); s = xadd<2>(s);
      if (qd == 0) { if (p < 64) RQ[p] = (1.0f / sqrtf(s + EPS)) * 0.08838834764831845f; else RK[p - 64] = 1.0f / sqrtf(s + EPS); } }
    __syncthreads();
    if (kind == 0) {
#pragma unroll
        for (int i = 0; i < 64; ++i) { const float qn = val[i] * RQ[i]; QL[i * 136 + ch] = f2bf(qn); QGT[i * 128 + ch] = f2bf(qn * EG[i]); }
    } else if (kind == 1) {
        bf16* kdp = launder_g(KDT + (size_t)ch * 64);
#pragma unroll
        for (int i8 = 0; i8 < 8; ++i8) { float kd[8];
#pragma unroll
            for (int j = 0; j < 8; ++j) { const int i = i8 * 8 + j; const float kn = val[i] * RK[i]; KL[i * 136 + ch] = f2bf(kn); kd[j] = kn * DG[i]; RHS[i * 256 + ch] = BETA[i] * EG[i] * kn; }
            { const int s_ = i8 >> 2, a_ = (i8 >> 1) & 1, g_ = 2 * (i8 & 1);
              v2u o0, o1; o0.x = pk2(kd[0], kd[1]); o0.y = pk2(kd[2], kd[3]); o1.x = pk2(kd[4], kd[5]); o1.y = pk2(kd[6], kd[7]);
              __hip_atomic_store((u64*)(kdp + 32 * s_ + 8 * g_ + 4 * a_), (u64)o0.x | ((u64)o0.y << 32), __ATOMIC_RELAXED, __HIP_MEMORY_SCOPE_AGENT);
              __hip_atomic_store((u64*)(kdp + 32 * s_ + 8 * (g_ + 1) + 4 * a_), (u64)o1.x | ((u64)o1.y << 32), __ATOMIC_RELAXED, __HIP_MEMORY_SCOPE_AGENT); } }
    } else if (kind == 2) {
#pragma unroll
        for (int i = 0; i < 64; ++i) RHS[i * 256 + 128 + ch] = BETA[i] * val[i];
    }
    __syncthreads();
    {
        const int rt = wave & 3, g = lane >> 4, n = lane & 15;
        LAS bf16* As = (wave < 4) ? KL : QL;
        f32x4 acc[4];
#pragma unroll
        for (int t = 0; t < 4; ++t) acc[t] = (f32x4){0.f, 0.f, 0.f, 0.f};
#pragma unroll
        for (int s = 0; s < 4; ++s) { const bf16x8 a = *(const LAS bf16x8*)(As + (16 * rt + n) * 136 + 32 * s + 8 * g);
#pragma unroll
            for (int t = 0; t < 4; ++t) { const bf16x8 b = *(const LAS bf16x8*)(KL + (16 * t + n) * 136 + 32 * s + 8 * g); acc[t] = mfma16(a, b, acc[t]); } }
#pragma unroll
        for (int t = 0; t < 4; ++t) { const int j = 16 * t + n; const float gj = GC[j];
#pragma unroll
            for (int r = 0; r < 4; ++r) { const int i = 16 * rt + 4 * g + r; const float d = __expf(fminf(GC[i] - gj, 0.f));
                if (wave < 4) LM[i * 64 + j] = (i > j) ? BETA[i] * acc[t][r] * d : 0.f;
                else acc[t][r] = (i >= j) ? acc[t][r] * d : 0.f; } }
        __syncthreads();
        if (wave >= 4) {
#pragma unroll
            for (int t = 0; t < 4; ++t)
#pragma unroll
                for (int r = 0; r < 4; ++r) QL[(16 * rt + 4 * g + r) * 64 + 16 * t + n] = f2bf(acc[t][r]); }
    }
    const bool solver = (kind == 1 || kind == 2);
    float x[64];
    if (solver) {
#pragma unroll
        for (int i = 0; i < 32; ++i) x[i] = RHS[i * 256 + (tid - 128)];
#pragma unroll
        for (int i = 0; i < 32; ++i) {
            float p[4] = {0.f, 0.f, 0.f, 0.f};
#pragma unroll
            for (int j4 = 0; j4 < (i + 3) / 4; ++j4) { const f32x4 lv = *(const LAS f32x4*)(LM + i * 64 + 4 * j4);
#pragma unroll
                for (int jj = 0; jj < 4; ++jj) if (4 * j4 + jj < i) p[jj] += lv[jj] * x[4 * j4 + jj]; }
            x[i] = x[i] - ((p[0] + p[1]) + (p[2] + p[3]));
            RHS[i * 256 + (tid - 128)] = x[i];
            if (i & 1) asm volatile("" ::: "memory");
        }
    }
    __syncthreads();
    { const int g = lane >> 4, n = lane & 15;
#pragma unroll
      for (int q = 0; q < 4; ++q) { const int nt = 2 * wave + (q & 1), mt = q >> 1;
          LAS float* cp = RHS + (32 + 16 * mt + 4 * g) * 256 + 16 * nt + n;
          f32x4 c = (f32x4){cp[0], cp[256], cp[512], cp[768]};
#pragma unroll
          for (int ks = 0; ks < 8; ++ks) c = __builtin_amdgcn_mfma_f32_16x16x4f32(-LM[(32 + 16 * mt + n) * 64 + 4 * ks + g], RHS[(4 * ks + g) * 256 + 16 * nt + n], c, 0, 0, 0);
          cp[0] = c[0]; cp[256] = c[1]; cp[512] = c[2]; cp[768] = c[3]; } }
    __syncthreads();
    if (solver) {
#pragma unroll
        for (int i = 32; i < 64; ++i) x[i] = RHS[i * 256 + (tid - 128)];
#pragma unroll
        for (int i = 32; i < 64; ++i) {
            float p[4] = {0.f, 0.f, 0.f, 0.f};
#pragma unroll
            for (int j4 = 8; j4 < (i + 3) / 4; ++j4) { const f32x4 lv = *(const LAS f32x4*)(LM + i * 64 + 4 * j4);
#pragma unroll
                for (int jj = 0; jj < 4; ++jj) if (4 * j4 + jj < i) p[jj] += lv[jj] * x[4 * j4 + jj]; }
            x[i] = x[i] - ((p[0] + p[1]) + (p[2] + p[3]));
            if (i & 1) asm volatile("" ::: "memory");
        }
        if (kind == 1) {
            const int pos = (ch & ~31) | (((ch >> 2) & 3) << 3) | (((ch >> 4) & 1) << 2) | (ch & 3);
#pragma unroll
            for (int i = 0; i < 64; ++i) KL[i * 128 + pos] = f2bf(-x[i]);
        } else {
            const int ws_ = ch >> 4, n = ch & 15; bf16* u0p = launder_g(U0L + ((size_t)(ws_ * 4) * 64 + n) * 4);
#pragma unroll
            for (int t = 0; t < 4; ++t)
#pragma unroll
                for (int g = 0; g < 4; ++g) __hip_atomic_store((u64*)(u0p + (t * 64 + 16 * g) * 4), (u64)pk2(x[16 * t + 4 * g], x[16 * t + 4 * g + 1]) | ((u64)pk2(x[16 * t + 4 * g + 2], x[16 * t + 4 * g + 3]) << 32), __ATOMIC_RELAXED, __HIP_MEMORY_SCOPE_AGENT);
        }
    }
    __syncthreads();
    { const LAS unsigned char* qgt = F.lds + GP_QGT; const LAS unsigned char* wkt = F.lds + GP_KL; const LAS unsigned char* qkt = F.lds + GP_QL;
#pragma unroll
      for (int k = 0; k < 2; ++k) { const int o = (tid + 512 * k) * 16;
          st_wt16((unsigned char*)QG + o, *(const LAS bf16x8*)(qgt + o)); st_wt16((unsigned char*)WKN + o, *(const LAS bf16x8*)(wkt + o)); }
      st_wt16((unsigned char*)QKM + tid * 16, *(const LAS bf16x8*)(qkt + tid * 16)); }
    __syncthreads();
}

constexpr int SC_WK = 0, SC_KD = 17408, SC_BUF = 35840;
constexpr int CW_QH = 60032, CW_SDONE = 61056;
constexpr int CW_READY = 32768, CW_PROG = CW_READY + 8 * 1024;
constexpr size_t WS_SB = WS_QATT, WS_UB = WS_QATT + 34 * MiB;
static_assert((size_t)NITEM * 32768 <= 34 * MiB && WS_UB + (size_t)NITEM * 16384 <= WS_GREG + 90 * MiB, "SB/UB fit");
struct ScanStage { v4u R[4]; v2u U0n[4]; float gln; };
__device__ __forceinline__ void sc_load(FA, ScanStage& st, int it, int tid, int w, int lane) {
    const int r4 = tid >> 4, c4 = tid & 15, r3 = tid >> 3, c3 = tid & 7;
    const bf16* wk_ = (const bf16*)(F.ws + WS_WKN) + (size_t)it * 8192; const bf16* kd_ = (const bf16*)(F.ws + WS_KDT) + (size_t)it * 8192; const bf16* u0_ = (const bf16*)(F.ws + WS_U0L) + (size_t)it * 8192;
    st.R[0] = *(const v4u*)(wk_ + r4 * 128 + c4 * 8); st.R[1] = *(const v4u*)(wk_ + (r4 + 32) * 128 + c4 * 8);
    st.R[2] = *(const v4u*)(kd_ + r3 * 64 + c3 * 8); st.R[3] = *(const v4u*)(kd_ + (r3 + 64) * 64 + c3 * 8);
#pragma unroll
    for (int t = 0; t < 4; ++t) st.U0n[t] = *(const v2u*)(u0_ + ((size_t)(w * 4 + t) * 64 + lane) * 4);
    { int z_ = 0; asm volatile("" : "+v"(z_));
      st.gln = ((const float*)(F.ws + WS_GL))[it + z_]; }
}
__device__ __forceinline__ void sc_store(FA, const ScanStage& st, int buf, int tid) {
    const int r4 = tid >> 4, c4 = tid & 15, r3 = tid >> 3, c3 = tid & 7;
    LAS unsigned char* b_ = F.lds + buf * SC_BUF;
    *(LAS v4u*)(b_ + SC_WK + r4 * 272 + c4 * 16) = st.R[0]; *(LAS v4u*)(b_ + SC_WK + (r4 + 32) * 272 + c4 * 16) = st.R[1];
    *(LAS v4u*)(b_ + SC_KD + r3 * 144 + c3 * 16) = st.R[2]; *(LAS v4u*)(b_ + SC_KD + (r3 + 64) * 144 + c3 * 16) = st.R[3];
}
__device__ __forceinline__ void sc_chunk(FA, f32x4 (&S)[8], const v2u (&U0c)[4], float gl, int buf, int it, int w, int lane) {
    const int g = lane >> 4, n = lane & 15;
    const LAS unsigned char* b = F.lds + buf * SC_BUF;
    const unsigned fa = (unsigned)(n * 272 + g * 8), fk = (unsigned)(n * 144 + g * 8);
    unsigned char* sbp = F.ws + WS_SB + (((size_t)it * 8 + w) * 4 * 64 + lane) * 16;
    unsigned char* ubp = F.ws + WS_UB + (((size_t)it * 8 + w) * 2 * 64 + lane) * 16;
    bf16x8 Sb[4];
#pragma unroll
    for (int s = 0; s < 4; ++s) { Sb[s] = mk8(pk2(S[2 * s][0], S[2 * s][1]), pk2(S[2 * s][2], S[2 * s][3]), pk2(S[2 * s + 1][0], S[2 * s + 1][1]), pk2(S[2 * s + 1][2], S[2 * s + 1][3])); st_wt16(sbp + s * 1024, Sb[s]); }
    const unsigned fa2 = (unsigned)(n * 272 + g * 16), fk2 = (unsigned)(n * 144 + g * 16);
    bf16x8 fr[2][4];
    f32x4 U[4];
#pragma unroll
    for (int t = 0; t < 4; ++t) U[t] = (f32x4){bflo(U0c[t].x), bfhi(U0c[t].x), bflo(U0c[t].y), bfhi(U0c[t].y)};
#pragma unroll
    for (int hh = 0; hh < 2; ++hh) {
#pragma unroll
        for (int s = 0; s < 2; ++s)
#pragma unroll
            for (int t = 0; t < 4; ++t) fr[s][t] = *(const LAS bf16x8*)(b + SC_WK + fa2 + t * (16 * 272) + (2 * hh + s) * 64);
        __builtin_amdgcn_sched_barrier(0);
#pragma unroll
        for (int s = 0; s < 2; ++s)
#pragma unroll
            for (int t = 0; t < 4; ++t) U[t] = mfma16(fr[s][t], Sb[2 * hh + s], U[t]);
        __builtin_amdgcn_sched_barrier(0);
    }
#pragma unroll
    for (int t = 0; t < 8; ++t) S[t] = S[t] * gl;
    bf16x8 Ub[2];
#pragma unroll
    for (int s = 0; s < 2; ++s) {
#pragma unroll
        for (int t = 0; t < 8; ++t) fr[t >> 2][t & 3] = *(const LAS bf16x8*)(b + SC_KD + fk2 + t * (16 * 144) + s * 64);
        __builtin_amdgcn_sched_barrier(0);
        if (s == 0) {
#pragma unroll
            for (int q = 0; q < 2; ++q) { Ub[q] = mk8(pk2(U[2 * q][0], U[2 * q][1]), pk2(U[2 * q][2], U[2 * q][3]), pk2(U[2 * q + 1][0], U[2 * q + 1][1]), pk2(U[2 * q + 1][2], U[2 * q + 1][3])); st_wt16(ubp + q * 1024, Ub[q]); }
        }
#pragma unroll
        for (int t = 0; t < 8; ++t) S[t] = mfma16(fr[t >> 2][t & 3], Ub[s], S[t]);
        __builtin_amdgcn_sched_barrier(0);
    }
}
__device__ __forceinline__ void sc_wait_ready(const unsigned* flags, int cnt, int lane) {
    unsigned spins = 0;
    for (;;) {
        unsigned v = 1u; if (lane < cnt) v = __hip_atomic_load(flags + lane, __ATOMIC_RELAXED, __HIP_MEMORY_SCOPE_AGENT);
        if (__all(v != 0u)) break;
        __builtin_amdgcn_s_sleep(4);
        if (++spins > (1u << 20)) break;
    }
    __builtin_amdgcn_fence(__ATOMIC_ACQUIRE, "agent");
    asm volatile("s_waitcnt vmcnt(0)" ::: "memory");
}
__device__ __forceinline__ void gdn_scan_prompt(FA, int l, int sbk, int fl) {
    const int tid = F.tid, lane = F.lane, wv = F.wave, g = lane >> 4, n = lane & 15;
    const int seq = sbk >> 1, half = sbk & 1; const bool cw = wv < 4; const int w = half * 4 + (wv & 3);
    const int b = seq >> 2, h = seq & 3, it0 = b * 512 + h;
    const unsigned* ready = F.ctl + CW_READY + fl * 1024 + seq * 128;
    unsigned* prog = F.ctl + CW_PROG + ((fl * 8 + seq) * 2 + half) * 64;
    f32x4 S[8];
#pragma unroll
    for (int t = 0; t < 8; ++t) S[t] = (f32x4){0.f, 0.f, 0.f, 0.f};
    if (wv == 0) sc_wait_ready(ready, 9, lane);
    __syncthreads();
    ScanStage s0, s1, s2;
    v2u U0c[4]; float gl;
#define SC_ISSUE(K, ST) do { const int k_ = (K); if (k_ < 128) { \
        if ((k_ & 7) == 1 && k_ > 1) { if (wv == 0) sc_wait_ready(ready + k_, (128 - k_) < 8 ? (128 - k_) : 8, lane); __syncthreads(); } \
        sc_load(F, A, ST, it0 + k_ * 4, tid, w, lane); } } while (0)
#define SC_STEP(C, ST) do { const int c_ = (C); if (c_ < 128) { \
        if (cw) sc_chunk(F, A, S, U0c, gl, c_ & 1, it0 + c_ * 4, w, lane); \
        if (c_ + 1 < 128) { sc_store(F, A, ST, (c_ + 1) & 1, tid); _Pragma("unroll") for (int t = 0; t < 4; ++t) U0c[t] = ST.U0n[t]; gl = ST.gln; SC_ISSUE(c_ + 4, ST); } \
        __syncthreads(); \
        if (tid == 0 && c_ >= 3 && c_ + 1 < 128) __hip_atomic_store(prog, (unsigned)(c_ - 2), __ATOMIC_RELAXED, __HIP_MEMORY_SCOPE_AGENT); } } while (0)
    sc_load(F, A, s0, it0, tid, w, lane); sc_store(F, A, s0, 0, tid);
#pragma unroll
    for (int t = 0; t < 4; ++t) U0c[t] = s0.U0n[t];
    gl = s0.gln;
    SC_ISSUE(1, s1); SC_ISSUE(2, s2); SC_ISSUE(3, s0);
    __syncthreads();
    for (int c = 0; c < 128; c += 3) { SC_STEP(c, s1); SC_STEP(c + 1, s2); SC_STEP(c + 2, s0); }
#undef SC_ISSUE
#undef SC_STEP
    asm volatile("s_waitcnt vmcnt(0)" ::: "memory");
    __syncthreads();
    if (tid == 0) __hip_atomic_store(prog, 128u, __ATOMIC_RELAXED, __HIP_MEMORY_SCOPE_AGENT);
    float* Sout = F.out + O_PSG + ((size_t)(l * 2 + b) * 4 + h) * 16384;
    if (cw) {
#pragma unroll
    for (int t = 0; t < 8; ++t)
#pragma unroll
        for (int r = 0; r < 4; ++r) Sout[(size_t)(16 * t + 4 * g + r) * 128 + 16 * w + n] = S[t][r];
    }
}
constexpr int OI_QG = 0, OI_QK = 17408, OI_OT = 26624;
struct OPre { v4u z0, z1; };
__device__ __forceinline__ void gdn_o_pre(FA, int it, int row0, int ntok, int h, OPre& P) {
    const int tid = F.tid; const int r3 = tid >> 3, c3 = tid & 7;
    P.z0 = (v4u){0u, 0u, 0u, 0u}; P.z1 = (v4u){0u, 0u, 0u, 0u};
    if (r3 < ntok) { const bf16* zp = (const bf16*)(F.ws + WS_BIG) + ((size_t)row0 + r3) * NPROJ + PC_Z + h * 128 + c3 * 16; P.z0 = *(const v4u*)zp; P.z1 = *(const v4u*)(zp + 8); }
}
__device__ __forceinline__ void gdn_o_item(FA, int l, int it, int row0, int ntok, int h, const OPre& P) {
    const int tid = F.tid, lane = F.lane, w = F.wave, g = lane >> 4, n = lane & 15;
    { const int r4 = tid >> 4, c4 = tid & 15, r3 = tid >> 3, c3 = tid & 7;
      const bf16* qg_ = (const bf16*)(F.ws + WS_QG) + (size_t)it * 8192; const bf16* qk_ = (const bf16*)(F.ws + WS_QKM) + (size_t)it * 4096;
      const v4u a0 = *(const v4u*)(qg_ + r4 * 128 + c4 * 8), a1 = *(const v4u*)(qg_ + (r4 + 32) * 128 + c4 * 8), a2 = *(const v4u*)(qk_ + r3 * 64 + c3 * 8);
      *(LAS v4u*)(F.lds + OI_QG + r4 * 272 + c4 * 16) = a0; *(LAS v4u*)(F.lds + OI_QG + (r4 + 32) * 272 + c4 * 16) = a1; *(LAS v4u*)(F.lds + OI_QK + r3 * 144 + c3 * 16) = a2; }
    const unsigned char* sbp = F.ws + WS_SB + (((size_t)it * 8 + w) * 4 * 64 + lane) * 16;
    const unsigned char* ubp = F.ws + WS_UB + (((size_t)it * 8 + w) * 2 * 64 + lane) * 16;
    bf16x8 Sb[4], Ub[2];
#pragma unroll
    for (int s = 0; s < 4; ++s) Sb[s] = *(const bf16x8*)(sbp + s * 1024);
#pragma unroll
    for (int s = 0; s < 2; ++s) Ub[s] = *(const bf16x8*)(ubp + s * 1024);
    __syncthreads();
    const unsigned fa = (unsigned)(n * 272 + g * 8), fk = (unsigned)(n * 144 + g * 8);
    f32x4 O[4];
#pragma unroll
    for (int t = 0; t < 4; ++t) O[t] = (f32x4){0.f, 0.f, 0.f, 0.f};
#pragma unroll
    for (int s = 0; s < 4; ++s)
#pragma unroll
        for (int t = 0; t < 4; ++t) { const LAS unsigned char* p = F.lds + OI_QG + fa + t * (16 * 272) + s * 64; const v2u a0 = *(const LAS v2u*)p, a1 = *(const LAS v2u*)(p + 32);
            O[t] = mfma16(mk8(a0.x, a0.y, a1.x, a1.y), Sb[s], O[t]); }
#pragma unroll
    for (int s = 0; s < 2; ++s)
#pragma unroll
        for (int t = 0; t < 4; ++t) { const LAS unsigned char* p = F.lds + OI_QK + fk + t * (16 * 144) + s * 64; const v2u a0 = *(const LAS v2u*)p, a1 = *(const LAS v2u*)(p + 32);
            O[t] = mfma16(mk8(a0.x, a0.y, a1.x, a1.y), Ub[s], O[t]); }
    LAS float* OT = (LAS float*)(F.lds + OI_OT);
#pragma unroll
    for (int t = 0; t < 4; ++t)
#pragma unroll
        for (int r = 0; r < 4; ++r) OT[(16 * t + 4 * g + r) * 132 + 16 * w + n] = O[t][r];
    __syncthreads();
    { const int r = tid >> 3, c0 = (tid & 7) * 16;
      float o[16]; float ss = 0.f;
#pragma unroll
      for (int j = 0; j < 4; ++j) { const f32x4 v = *(const LAS f32x4*)(OT + r * 132 + c0 + 4 * j); o[4 * j] = v[0]; o[4 * j + 1] = v[1]; o[4 * j + 2] = v[2]; o[4 * j + 3] = v[3]; ss += (v[0] * v[0] + v[1] * v[1]) + (v[2] * v[2] + v[3] * v[3]); }
      ss = xadd<1>(ss); ss = xadd<2>(ss); ss = xadd<4>(ss);
      if (r < ntok) {
          const float rn = __builtin_amdgcn_rsqf(ss * (1.0f / 128.0f) + EPS);
          const size_t row = (size_t)row0 + r;
          const v4u z0 = P.z0, z1 = P.z1;
          const float z[16] = {bflo(z0.x), bfhi(z0.x), bflo(z0.y), bfhi(z0.y), bflo(z0.z), bfhi(z0.z), bflo(z0.w), bfhi(z0.w), bflo(z1.x), bfhi(z1.x), bflo(z1.y), bfhi(z1.y), bflo(z1.z), bfhi(z1.z), bflo(z1.w), bfhi(z1.w)};
          const float* gn = INP(I_GNG) + l * 128 + c0;
#pragma unroll
          for (int j = 0; j < 16; ++j) o[j] = o[j] * rn * gn[j] * silu_f(z[j]);
          v4u w0, w1; w0.x = pk2(o[0], o[1]); w0.y = pk2(o[2], o[3]); w0.z = pk2(o[4], o[5]); w0.w = pk2(o[6], o[7]); w1.x = pk2(o[8], o[9]); w1.y = pk2(o[10], o[11]); w1.z = pk2(o[12], o[13]); w1.w = pk2(o[14], o[15]);
          bf16* mp = (bf16*)(F.ws + WS_MIX) + row * 1024 + h * 128 + c0;
          *(v4u*)mp = w0; *(v4u*)(mp + 8) = w1; } }
    __syncthreads();
}
__device__ __forceinline__ void gdn_sample_scan(FA, int l, int it) {
    const int tid = F.tid, lane = F.lane, w = F.wave, g = lane >> 4, n = lane & 15;
    const int k = it - 1024, s_ = k >> 2, h = k & 3;
    __builtin_amdgcn_fence(__ATOMIC_ACQUIRE, "agent"); asm volatile("s_waitcnt vmcnt(0)" ::: "memory"); __syncthreads();
    const float* S0 = INP(I_SGDN) + ((size_t)(l * 16 + s_) * 4 + h) * 16384;
    f32x4 S[8];
#pragma unroll
    for (int t = 0; t < 8; ++t)
#pragma unroll
        for (int r = 0; r < 4; ++r) S[t][r] = S0[(size_t)(16 * t + 4 * g + r) * 128 + 16 * w + n];
    ScanStage st; sc_load(F, A, st, it, tid, w, lane); sc_store(F, A, st, 0, tid);
    __syncthreads();
    sc_chunk(F, A, S, st.U0n, st.gln, 0, it, w, lane);
    float* Sout = F.out + O_SSG + ((size_t)(l * 16 + s_) * 4 + h) * 16384;
#pragma unroll
    for (int t = 0; t < 8; ++t)
#pragma unroll
        for (int r = 0; r < 4; ++r) Sout[(size_t)(16 * t + 4 * g + r) * 128 + 16 * w + n] = S[t][r];
    asm volatile("s_waitcnt vmcnt(0)" ::: "memory"); __syncthreads();
}
__device__ __forceinline__ int gdn_item_of(int j) { return j < 1024 ? ((((j >> 2) & 1) * 128 + (j >> 3)) * 4 + (j & 3)) : j; }
constexpr int SW_KL = 0, SW_VT = 27648;
__device__ __forceinline__ void swa_item(FA, int l, int item) {
    const int tid = F.tid, lane = F.lane, w = F.wave, g = lane >> 4, n = lane & 15;
    const bool samp = item >= 512;
    const int hk = item & 1, sb = samp ? ((item - 512) >> 1) : (item >> 8), c = samp ? 0 : ((item >> 1) & 127);
    const int c0 = (c >= 2) ? c - 2 : 0;
    const int nkeys = samp ? 144 : (c - c0 + 1) * 64, nkp = (nkeys + 31) & ~31;
    const int krow0 = samp ? (MP + sb * 16 - 128) : (sb * SEQ + c0 * 64);
    const bf16* PROJ = (const bf16*)(F.ws + WS_BIG);
    LAS bf16* KL = (LAS bf16*)(F.lds + SW_KL); LAS bf16* VT = (LAS bf16*)(F.lds + SW_VT);
    const float* gk = INP(I_SKG) + l * 64;
    for (int idx = tid; idx < nkp * 8; idx += NWAVES * 64) {
        const int key = idx >> 3, ch = idx & 7;
        float kv[8], vv[8];
        if (key >= nkeys) {
#pragma unroll
            for (int j = 0; j < 8; ++j) { kv[j] = 0.f; vv[j] = 0.f; }
        } else if (samp && key < 128) {
            const float* kp = INP(I_CSK) + ((size_t)(l * 16 + sb) * 128 + key) * 128 + hk * 64 + ch * 8; const float* vp = INP(I_CSV) + ((size_t)(l * 16 + sb) * 128 + key) * 128 + hk * 64 + ch * 8;
            const f32x4 k0 = *(const f32x4*)kp, k1 = *(const f32x4*)(kp + 4), v0 = *(const f32x4*)vp, v1 = *(const f32x4*)(vp + 4);
#pragma unroll
            for (int j = 0; j < 4; ++j) { kv[j] = k0[j]; kv[4 + j] = k1[j]; vv[j] = v0[j]; vv[4 + j] = v1[j]; }
        } else {
            const size_t row = (size_t)(krow0 + key);
            const v4u kb = *(const v4u*)(PROJ + row * NPROJ + PC_SK + hk * 64 + ch * 8), vb = *(const v4u*)(PROJ + row * NPROJ + PC_SV + hk * 64 + ch * 8);
            kv[0] = bflo(kb.x); kv[1] = bfhi(kb.x); kv[2] = bflo(kb.y); kv[3] = bfhi(kb.y); kv[4] = bflo(kb.z); kv[5] = bfhi(kb.z); kv[6] = bflo(kb.w); kv[7] = bfhi(kb.w);
            vv[0] = bflo(vb.x); vv[1] = bfhi(vb.x); vv[2] = bflo(vb.y); vv[3] = bfhi(vb.y); vv[4] = bflo(vb.z); vv[5] = bfhi(vb.z); vv[6] = bflo(vb.w); vv[7] = bfhi(vb.w);
            float s = 0.f;
#pragma unroll
            for (int j = 0; j < 8; ++j) s += kv[j] * kv[j];
            s = xadd<1>(s); s = xadd<2>(s); s = xadd<4>(s);
            const float r = __builtin_amdgcn_rsqf(s * (1.0f / 64.0f) + EPS);
#pragma unroll
            for (int j = 0; j < 8; ++j) kv[j] = kv[j] * r * gk[ch * 8 + j];
            float* ok = nullptr; float* ov = nullptr;
            if (samp) { const size_t o = ((size_t)(l * 16 + sb) * 16 + (key - 128)) * 128 + hk * 64 + ch * 8; ok = F.out + O_SSK + o; ov = F.out + O_SSV + o; }
            else if (c >= 126 && key >= (c - c0) * 64) { const int t = c * 64 + (key - (c - c0) * 64) - (SEQ - 128);
                const size_t o = ((size_t)(l * 2 + sb) * 128 + t) * 128 + hk * 64 + ch * 8; ok = F.out + O_PSK + o; ov = F.out + O_PSV + o; }
            if (ok) { *(f32x4*)ok = (f32x4){kv[0], kv[1], kv[2], kv[3]}; *(f32x4*)(ok + 4) = (f32x4){kv[4], kv[5], kv[6], kv[7]};
                      *(f32x4*)ov = (f32x4){vv[0], vv[1], vv[2], vv[3]}; *(f32x4*)(ov + 4) = (f32x4){vv[4], vv[5], vv[6], vv[7]}; }
        }
        v4u kw; kw.x = pk2(kv[0], kv[1]); kw.y = pk2(kv[2], kv[3]); kw.z = pk2(kv[4], kv[5]); kw.w = pk2(kv[6], kv[7]);
        *(LAS v4u*)(KL + key * 72 + ch * 8) = kw;
#pragma unroll
        for (int j = 0; j < 8; ++j) VT[(ch * 8 + j) * 200 + key] = f2bf(vv[j]);
    }
    __syncthreads();
    const bool active = samp ? (w < 2) : true;
    if (active) {
        const int head = hk * 2 + (samp ? w : (w >> 2)), tok0 = samp ? 0 : 16 * (w & 3);
        const size_t qrow = (size_t)(samp ? (MP + sb * 16) : (sb * SEQ + c * 64)) + tok0 + n;
        const float* gq = INP(I_SQG) + l * 64;
        float q[16];
#pragma unroll
        for (int s = 0; s < 2; ++s) { const v4u qb = *(const v4u*)(PROJ + qrow * NPROJ + PC_SQ + head * 64 + 32 * s + 8 * g);
            q[8 * s + 0] = bflo(qb.x); q[8 * s + 1] = bfhi(qb.x); q[8 * s + 2] = bflo(qb.y); q[8 * s + 3] = bfhi(qb.y); q[8 * s + 4] = bflo(qb.z); q[8 * s + 5] = bfhi(qb.z); q[8 * s + 6] = bflo(qb.w); q[8 * s + 7] = bfhi(qb.w); }
        float ss = 0.f;
#pragma unroll
        for (int j = 0; j < 16; ++j) ss += q[j] * q[j];
        ss = xadd<16>(ss); ss = xadd32(ss);
        const float sc = (1.0f / sqrtf(ss * (1.0f / 64.0f) + EPS)) * 0.125f;
        bf16x8 qf[2];
#pragma unroll
        for (int s = 0; s < 2; ++s) { float t[8];
#pragma unroll
            for (int j = 0; j < 8; ++j) t[j] = q[8 * s + j] * sc * gq[32 * s + 8 * g + j];
            qf[s] = mk8(pk2(t[0], t[1]), pk2(t[2], t[3]), pk2(t[4], t[5]), pk2(t[6], t[7])); }
        const float sink = INP(I_SINK)[l * 4 + head];
        f32x4 st[12]; float mx = sink;
#pragma unroll
        for (int t = 0; t < 12; ++t) {
            if (16 * t < nkp) { f32x4 a = (f32x4){0.f, 0.f, 0.f, 0.f};
#pragma unroll
                for (int s = 0; s < 2; ++s) a = mfma16(*(const LAS bf16x8*)(KL + (16 * t + n) * 72 + 32 * s + 8 * g), qf[s], a);
#pragma unroll
                for (int r = 0; r < 4; ++r) if (16 * t + 4 * g + r >= nkeys) a[r] = -1e30f;
                st[t] = a; }
            else st[t] = (f32x4){-1e30f, -1e30f, -1e30f, -1e30f};
#pragma unroll
            for (int r = 0; r < 4; ++r) mx = fmaxf(mx, st[t][r]);
        }
        mx = xmax<16>(mx); mx = xmax32(mx);
        float sum = 0.f;
#pragma unroll
        for (int t = 0; t < 12; ++t)
#pragma unroll
            for (int r = 0; r < 4; ++r) { const float p = __expf(st[t][r] - mx); st[t][r] = p; sum += p; }
        sum = xadd<16>(sum); sum = xadd32(sum);
        const float inv = 1.0f / (sum + __expf(sink - mx));
        bf16x8 Pb[6];
#pragma unroll
        for (int k = 0; k < 6; ++k) Pb[k] = mk8(pk2(st[2 * k][0], st[2 * k][1]), pk2(st[2 * k][2], st[2 * k][3]), pk2(st[2 * k + 1][0], st[2 * k + 1][1]), pk2(st[2 * k + 1][2], st[2 * k + 1][3]));
        bf16* MIX = (bf16*)(F.ws + WS_MIX);
#pragma unroll
        for (int th = 0; th < 4; ++th) { f32x4 a = (f32x4){0.f, 0.f, 0.f, 0.f};
#pragma unroll
            for (int k = 0; k < 6; ++k) if (32 * k < nkp) { const LAS bf16* p = VT + (16 * th + n) * 200 + 32 * k + 4 * g; const v2u a0 = *(const LAS v2u*)p, a1 = *(const LAS v2u*)(p + 16);
                a = mfma16(mk8(a0.x, a0.y, a1.x, a1.y), Pb[k], a); }
            v2u o; o.x = pk2(a[0] * inv, a[1] * inv); o.y = pk2(a[2] * inv, a[3] * inv);
            *(v2u*)(MIX + qrow * 1024 + 512 + head * 64 + 16 * th + 4 * g) = o; }
    }
    __syncthreads();
}
__device__ __forceinline__ void sc_row(FA, int l, int row) {
    const int lane = F.lane, c = 4 * lane;
    const bool samp = row >= MP; const int t = samp ? ((row - MP) & 15) : (row & (SEQ - 1)), sb = samp ? ((row - MP) >> 4) : (row >> 13);
    const bf16* PROJ = (const bf16*)(F.ws + WS_BIG);
    float p[3][4];
#pragma unroll
    for (int d = 0; d < 3; ++d) { const int tt = t - 2 + d;
        if (tt >= 0) { const bf16* pr = PROJ + (size_t)(row - 2 + d) * NPROJ; const v2u a = *(const v2u*)(pr + PC_SCC + c), b = *(const v2u*)(pr + PC_SCH + c);
            p[d][0] = bflo(a.x) * bflo(b.x); p[d][1] = bfhi(a.x) * bfhi(b.x); p[d][2] = bflo(a.y) * bflo(b.y); p[d][3] = bfhi(a.y) * bfhi(b.y); }
        else if (samp) { const f32x4 v = *(const f32x4*)(INP(I_SSC) + ((size_t)(l * 16 + sb) * 2 + (tt + 2)) * 256 + c); p[d][0] = v[0]; p[d][1] = v[1]; p[d][2] = v[2]; p[d][3] = v[3]; }
        else { p[d][0] = 0.f; p[d][1] = 0.f; p[d][2] = 0.f; p[d][3] = 0.f; } }
    const float* wsc = INP(I_WSC) + (size_t)l * 3 * 256 + c;
    const f32x4 w0 = *(const f32x4*)wsc, w1 = *(const f32x4*)(wsc + 256), w2 = *(const f32x4*)(wsc + 512);
    const v2u bb = *(const v2u*)(PROJ + (size_t)row * NPROJ + PC_SCB + c);
    const float scb[4] = {bflo(bb.x), bfhi(bb.x), bflo(bb.y), bfhi(bb.y)};
    float o[4];
#pragma unroll
    for (int j = 0; j < 4; ++j) o[j] = scb[j] * ((w0[j] * p[0][j] + w1[j] * p[1][j]) + w2[j] * p[2][j]);
    v2u ow; ow.x = pk2(o[0], o[1]); ow.y = pk2(o[2], o[3]);
    *(v2u*)((bf16*)(F.ws + WS_MIX) + (size_t)row * 1024 + 768 + c) = ow;
    const int tl = samp ? 14 : SEQ - 2;
    if (t >= tl) { float* dst = samp ? F.out + O_SSC + ((size_t)(l * 16 + sb) * 2 + (t - tl)) * 256 + c : F.out + O_PSC + ((size_t)(l * 2 + sb) * 2 + (t - tl)) * 256 + c;
        *(f32x4*)dst = (f32x4){p[2][0], p[2][1], p[2][2], p[2][3]}; }
}
__device__ __forceinline__ void xattn_prompt_item(FA, int l, int pm, int h) {
    const int tid = F.tid, lane = F.lane, w = F.wave, g = lane >> 4, n = lane & 15;
    const int b = pm >> 5;
    const bf16* K = (const bf16*)(F.ws + WS_MEMK) + ((size_t)l * 512 + b * 256) * 1024 + h * 256;
    const bf16* VT = (const bf16*)(F.ws + WS_MEMVT) + (size_t)((l * 2 + b) * 4 + h) * 65536;
    const bf16* QA = (const bf16*)(F.ws + WS_QATT);
    { v4u kr[8];
#pragma unroll
      for (int hb = 0; hb < 2; ++hb) {
#pragma unroll
        for (int i = 0; i < 8; ++i) { const int idx = tid + 512 * (8 * hb + i), key = idx >> 5, ch = idx & 31; kr[i] = *(const v4u*)(K + (size_t)key * 1024 + ch * 8); }
#pragma unroll
        for (int i = 0; i < 8; ++i) { const int idx = tid + 512 * (8 * hb + i), key = idx >> 5, ch = idx & 31; *(LAS v4u*)(F.lds + key * 528 + ch * 16) = kr[i]; } } }
    const size_t row0 = (size_t)pm * 256 + w * 32 + n;
    const float* gq = INP(I_MQG) + l * 256;
    bf16x8 q0[8], q1[8];
    { const f32x4 a0 = *(const f32x4*)((const float*)(F.ws + WS_QSS) + row0 * 16 + h * 4), a1 = *(const f32x4*)((const float*)(F.ws + WS_QSS) + (row0 + 16) * 16 + h * 4);
      const float r0 = (1.0f / sqrtf(((a0[0] + a0[1]) + (a0[2] + a0[3])) * (1.0f / 256.0f) + EPS)) * 0.0625f, r1 = (1.0f / sqrtf(((a1[0] + a1[1]) + (a1[2] + a1[3])) * (1.0f / 256.0f) + EPS)) * 0.0625f;
#pragma unroll
      for (int s = 0; s < 8; ++s) { const float* gg = gq + 32 * s + 8 * g;
          const v4u x = *(const v4u*)(QA + row0 * 1024 + h * 256 + 32 * s + 8 * g), y = *(const v4u*)(QA + (row0 + 16) * 1024 + h * 256 + 32 * s + 8 * g);
          q0[s] = mk8(pk2(bflo(x.x) * r0 * gg[0], bfhi(x.x) * r0 * gg[1]), pk2(bflo(x.y) * r0 * gg[2], bfhi(x.y) * r0 * gg[3]), pk2(bflo(x.z) * r0 * gg[4], bfhi(x.z) * r0 * gg[5]), pk2(bflo(x.w) * r0 * gg[6], bfhi(x.w) * r0 * gg[7]));
          q1[s] = mk8(pk2(bflo(y.x) * r1 * gg[0], bfhi(y.x) * r1 * gg[1]), pk2(bflo(y.y) * r1 * gg[2], bfhi(y.y) * r1 * gg[3]), pk2(bflo(y.z) * r1 * gg[4], bfhi(y.z) * r1 * gg[5]), pk2(bflo(y.w) * r1 * gg[6], bfhi(y.w) * r1 * gg[7])); } }
    __syncthreads();
    bf16x8 P0[8], P1[8]; float inv0, inv1;
    { f32x4 st0[16], st1[16];
      const LAS unsigned char* kb = F.lds + n * 528 + g * 16;
#pragma unroll
      for (int t = 0; t < 16; ++t) { f32x4 a0 = (f32x4){0.f, 0.f, 0.f, 0.f}, a1 = (f32x4){0.f, 0.f, 0.f, 0.f};
#pragma unroll
          for (int s = 0; s < 8; ++s) { const bf16x8 a = *(const LAS bf16x8*)(kb + t * (16 * 528) + s * 64); a0 = mfma16(a, q0[s], a0); a1 = mfma16(a, q1[s], a1); }
          st0[t] = a0; st1[t] = a1; }
      float m0 = -1e30f, m1 = -1e30f;
#pragma unroll
      for (int t = 0; t < 16; ++t)
#pragma unroll
          for (int r = 0; r < 4; ++r) { m0 = fmaxf(m0, st0[t][r]); m1 = fmaxf(m1, st1[t][r]); }
      m0 = xmax<16>(m0); m0 = xmax32(m0); m1 = xmax<16>(m1); m1 = xmax32(m1);
      float s0 = 0.f, s1 = 0.f;
#pragma unroll
      for (int t = 0; t < 16; ++t)
#pragma unroll
          for (int r = 0; r < 4; ++r) { const float p0 = __expf(st0[t][r] - m0), p1 = __expf(st1[t][r] - m1); st0[t][r] = p0; st1[t][r] = p1; s0 += p0; s1 += p1; }
      s0 = xadd<16>(s0); s0 = xadd32(s0); s1 = xadd<16>(s1); s1 = xadd32(s1);
      inv0 = 1.0f / s0; inv1 = 1.0f / s1;
#pragma unroll
      for (int k = 0; k < 8; ++k) { P0[k] = mk8(pk2(st0[2 * k][0], st0[2 * k][1]), pk2(st0[2 * k][2], st0[2 * k][3]), pk2(st0[2 * k + 1][0], st0[2 * k + 1][1]), pk2(st0[2 * k + 1][2], st0[2 * k + 1][3]));
                                    P1[k] = mk8(pk2(st1[2 * k][0], st1[2 * k][1]), pk2(st1[2 * k][2], st1[2 * k][3]), pk2(st1[2 * k + 1][0], st1[2 * k + 1][1]), pk2(st1[2 * k + 1][2], st1[2 * k + 1][3])); } }
    { v4u vr[8];
#pragma unroll
      for (int i = 0; i < 8; ++i) { const int idx = tid + 512 * i, hd = idx >> 5, ch = idx & 31; vr[i] = *(const v4u*)(VT + (size_t)hd * 256 + ch * 8); }
      __syncthreads();
#pragma unroll
      for (int i = 0; i < 8; ++i) { const int idx = tid + 512 * i, hd = idx >> 5, ch = idx & 31; *(LAS v4u*)(F.lds + hd * 528 + ch * 16) = vr[i]; }
#pragma unroll
      for (int i = 8; i < 16; ++i) { const int idx = tid + 512 * i, hd = idx >> 5, ch = idx & 31; vr[i - 8] = *(const v4u*)(VT + (size_t)hd * 256 + ch * 8); }
#pragma unroll
      for (int i = 8; i < 16; ++i) { const int idx = tid + 512 * i, hd = idx >> 5, ch = idx & 31; *(LAS v4u*)(F.lds + hd * 528 + ch * 16) = vr[i - 8]; } }
    __syncthreads();
    { const LAS unsigned char* vb = F.lds + n * 528 + g * 16;
      bf16* o0p = (bf16*)(F.ws + WS_ATT) + row0 * 1024 + h * 256 + 4 * g; bf16* o1p = o0p + 16 * 1024;
#pragma unroll 4
      for (int th = 0; th < 16; ++th) { f32x4 a0 = (f32x4){0.f, 0.f, 0.f, 0.f}, a1 = (f32x4){0.f, 0.f, 0.f, 0.f};
#pragma unroll
          for (int k = 0; k < 8; ++k) { const bf16x8 a = *(const LAS bf16x8*)(vb + th * (16 * 528) + k * 64); a0 = mfma16(a, P0[k], a0); a1 = mfma16(a, P1[k], a1); }
          v2u o; o.x = pk2(a0[0] * inv0, a0[1] * inv0); o.y = pk2(a0[2] * inv0, a0[3] * inv0); *(v2u*)(o0p + 16 * th) = o;
          o.x = pk2(a1[0] * inv1, a1[1] * inv1); o.y = pk2(a1[2] * inv1, a1[3] * inv1); *(v2u*)(o1p + 16 * th) = o; } }
    __syncthreads();
}
constexpr int XS_RED = 0, XS_SUM = 512, XS_PL = 1024;
__device__ __forceinline__ void xattn_sample_item(FA, int l, int item) {
    const int lane = F.lane, w = F.wave, g = lane >> 4, n = lane & 15;
    const int s_ = item >> 2, h = item & 3;
    const float* Kc = INP(I_CMK) + ((size_t)(l * 16 + s_) * 256) * 1024 + h * 256;
    const float* Vc = INP(I_CMV) + ((size_t)(l * 16 + s_) * 256) * 1024 + h * 256;
    LAS float* RED = (LAS float*)(F.lds + XS_RED); LAS float* SUM = (LAS float*)(F.lds + XS_SUM); LAS bf16* PL = (LAS bf16*)(F.lds + XS_PL);
    bf16* QA = (bf16*)(F.ws + WS_QATT);
    const size_t row = (size_t)MP + s_ * 16 + n;
    const f32x4 qs = *(const f32x4*)((const float*)(F.ws + WS_QSS) + row * 16 + h * 4);
    const float rq = (1.0f / sqrtf(((qs[0] + qs[1]) + (qs[2] + qs[3])) * (1.0f / 256.0f) + EPS)) * 0.0625f;
    const float* gq = INP(I_MQG) + l * 256;
    bf16x8 qf[8];
#pragma unroll
    for (int s = 0; s < 8; ++s) { const v4u qb = *(const v4u*)(QA + row * 1024 + h * 256 + 32 * s + 8 * g); const float* gg = gq + 32 * s + 8 * g;
        qf[s] = mk8(pk2(bflo(qb.x) * rq * gg[0], bfhi(qb.x) * rq * gg[1]), pk2(bflo(qb.y) * rq * gg[2], bfhi(qb.y) * rq * gg[3]),
                    pk2(bflo(qb.z) * rq * gg[4], bfhi(qb.z) * rq * gg[5]), pk2(bflo(qb.w) * rq * gg[6], bfhi(qb.w) * rq * gg[7])); }
    f32x4 st[2]; float mx = -1e30f;
#pragma unroll
    for (int t = 0; t < 2; ++t) { f32x4 a = (f32x4){0.f, 0.f, 0.f, 0.f};
#pragma unroll
        for (int s = 0; s < 8; ++s) { const float* kp = Kc + (size_t)(32 * w + 16 * t + n) * 1024 + 32 * s + 8 * g; const f32x4 k0 = *(const f32x4*)kp, k1 = *(const f32x4*)(kp + 4);
            a = mfma16(mk8(pk2(k0[0], k0[1]), pk2(k0[2], k0[3]), pk2(k1[0], k1[1]), pk2(k1[2], k1[3])), qf[s], a); }
        st[t] = a;
#pragma unroll
        for (int r = 0; r < 4; ++r) mx = fmaxf(mx, a[r]); }
    mx = xmax<16>(mx); mx = xmax32(mx);
    if (g == 0) RED[w * 16 + n] = mx;
    __syncthreads();
    float gm = RED[n];
#pragma unroll
    for (int j = 1; j < 8; ++j) gm = fmaxf(gm, RED[j * 16 + n]);
    float sum = 0.f;
#pragma unroll
    for (int t = 0; t < 2; ++t) {
#pragma unroll
        for (int r = 0; r < 4; ++r) { const float p = __expf(st[t][r] - gm); st[t][r] = p; sum += p; }
        v2u pw; pw.x = pk2(st[t][0], st[t][1]); pw.y = pk2(st[t][2], st[t][3]);
        *(LAS v2u*)(PL + n * 264 + 32 * w + 16 * t + 4 * g) = pw; }
    sum = xadd<16>(sum); sum = xadd32(sum);
    if (g == 0) SUM[w * 16 + n] = sum;
    __syncthreads();
    float tot = 0.f;
#pragma unroll
    for (int j = 0; j < 8; ++j) tot += SUM[j * 16 + n];
    const float inv = 1.0f / tot;
#pragma unroll
    for (int th = 0; th < 2; ++th) { f32x4 a = (f32x4){0.f, 0.f, 0.f, 0.f};
#pragma unroll
        for (int k = 0; k < 8; ++k) { const float* vp = Vc + (size_t)(32 * k + 8 * g) * 1024 + 32 * w + 16 * th + n;
            const bf16x8 av = mk8(pk2(vp[0], vp[1024]), pk2(vp[2048], vp[3072]), pk2(vp[4096], vp[5120]), pk2(vp[6144], vp[7168]));
            a = mfma16(av, *(const LAS bf16x8*)(PL + n * 264 + 32 * k + 8 * g), a); }
        v2u o; o.x = pk2(a[0] * inv, a[1] * inv); o.y = pk2(a[2] * inv, a[3] * inv);
        *(v2u*)((bf16*)(F.ws + WS_ATT) + row * 1024 + h * 256 + 32 * w + 16 * th + 4 * g) = o; }
    __syncthreads();
}
__device__ __forceinline__ void cg_unpack(const v4u a, float (&o)[8]) { o[0] = bflo(a.x); o[1] = bfhi(a.x); o[2] = bflo(a.y); o[3] = bfhi(a.y); o[4] = bflo(a.z); o[5] = bfhi(a.z); o[6] = bflo(a.w); o[7] = bfhi(a.w); }
template <int NROWS> __device__ __forceinline__ void convgate_task(FA, int l, int run, int chk) {
    const int j0 = chk * 8, row0 = run * 16;
    const bool samp = row0 >= MP; const int sb = (row0 - MP) >> 4;
    const bf16* U = (const bf16*)(F.ws + WS_BIG);
    const float* wf = INP(I_WFC) + (size_t)l * 3 * NUP;
    float wg[3][8], wv[3][8];
#pragma unroll
    for (int d = 0; d < 3; ++d) { const f32x4 a0 = *(const f32x4*)(wf + d * NUP + j0), a1 = *(const f32x4*)(wf + d * NUP + j0 + 4), b0 = *(const f32x4*)(wf + d * NUP + DFF + j0), b1 = *(const f32x4*)(wf + d * NUP + DFF + j0 + 4);
#pragma unroll
        for (int j = 0; j < 4; ++j) { wg[d][j] = a0[j]; wg[d][4 + j] = a1[j]; wv[d][j] = b0[j]; wv[d][4 + j] = b1[j]; } }
    float g2[8], g1[8], v2[8], v1[8];
    if (samp) { const float* st = INP(I_SFFN) + ((size_t)(l * 16 + sb) * 2) * NUP + j0;
#pragma unroll
        for (int j = 0; j < 8; ++j) { g2[j] = st[j]; v2[j] = st[DFF + j]; g1[j] = st[NUP + j]; v1[j] = st[NUP + DFF + j]; } }
    else if ((row0 & (SEQ - 1)) == 0) {
#pragma unroll
        for (int j = 0; j < 8; ++j) { g2[j] = 0.f; g1[j] = 0.f; v2[j] = 0.f; v1[j] = 0.f; } }
    else { const bf16* p2 = U + (size_t)(row0 - 2) * NUP + j0; cg_unpack(*(const v4u*)p2, g2); cg_unpack(*(const v4u*)(p2 + DFF), v2); cg_unpack(*(const v4u*)(p2 + NUP), g1); cg_unpack(*(const v4u*)(p2 + NUP + DFF), v1); }
    const bf16* pu = launder_g(U + (size_t)row0 * NUP + j0);
    bf16* pg = launder_g((bf16*)(F.ws + WS_GREG) + (size_t)row0 * DFF + j0);
#pragma unroll 2
    for (int r = 0; r < NROWS; ++r) {
        float g0[8], v0[8]; cg_unpack(*(const v4u*)pu, g0); cg_unpack(*(const v4u*)(pu + DFF), v0);
        float o[8];
#pragma unroll
        for (int j = 0; j < 8; ++j) { const float yg = (wg[0][j] * g2[j] + wg[1][j] * g1[j]) + wg[2][j] * g0[j], yv = (wv[0][j] * v2[j] + wv[1][j] * v1[j]) + wv[2][j] * v0[j]; o[j] = silu_f(yg) * yv;
            g2[j] = g1[j]; g1[j] = g0[j]; v2[j] = v1[j]; v1[j] = v0[j]; }
        v4u ow; ow.x = pk2(o[0], o[1]); ow.y = pk2(o[2], o[3]); ow.z = pk2(o[4], o[5]); ow.w = pk2(o[6], o[7]);
        *(v4u*)pg = ow;
        pu += NUP; pg += DFF;
    }
}
template <int MODE> __device__ __forceinline__ void skinny_item(FA, const bf16* Asmp, const bf16* Bt, int K, int item, const float* Xs, float* Yo) {
    const int lane = F.lane, w = F.wave, g = lane >> 4, n = lane & 15;
    const int mg = item >> 4, nt = item & 15, j = w & 3, kh = w >> 2, Ks = K >> 3, ns = Ks >> 5;
    const bf16* ap = Asmp + (size_t)(mg * 16 + n) * K + w * Ks + 8 * g;
    const bf16* bp = Bt + (size_t)(nt * 64 + n) * K + w * Ks + 8 * g;
    const size_t bs = (size_t)16 * K;
    float pre[4] = {0.f, 0.f, 0.f, 0.f};
    if (kh == 0) {
#pragma unroll
        for (int r = 0; r < 4; ++r) { const size_t row = (size_t)MP + mg * 16 + 4 * g + r; const size_t o = row * 1024 + nt * 64 + 16 * j + n;
            if (MODE == 0) pre[r] = Xs ? Xs[o - (size_t)MP * 1024] : bf2f(((const bf16*)(F.ws + WS_HB))[o]);
            else pre[r] = pg8::row_scale16((const float*)(F.ws + WS_SS), (int)row, 1.0f / 1024.0f); } }
    f32x4 cc[4];
#pragma unroll
    for (int t = 0; t < 4; ++t) cc[t] = (f32x4){0.f, 0.f, 0.f, 0.f};
    for (int s0 = 0; s0 < ns; s0 += 6) {
        bf16x8 a[6], b[6][4];
#pragma unroll
        for (int u = 0; u < 6; ++u) if (s0 + u < ns) { a[u] = *(const bf16x8*)(ap + (s0 + u) * 32);
#pragma unroll
            for (int t = 0; t < 4; ++t) b[u][t] = *(const bf16x8*)(bp + t * bs + (s0 + u) * 32); }
#pragma unroll
        for (int u = 0; u < 6; ++u) if (s0 + u < ns) {
#pragma unroll
            for (int t = 0; t < 4; ++t) cc[t] = mfma16(a[u], b[u][t], cc[t]); }
    }
    LAS f32x4* RED = (LAS f32x4*)F.lds;
    LAS float* PART = (LAS float*)(F.lds + 32768);
#pragma unroll
    for (int t = 0; t < 4; ++t) RED[(w * 4 + t) * 64 + lane] = cc[t];
    __syncthreads();
    float* SS = (float*)(F.ws + WS_SS);
    if (kh == 0) {
        f32x4 c = RED[j * 64 + lane];
#pragma unroll
        for (int sl = 1; sl < 8; ++sl) c = c + RED[(sl * 4 + j) * 64 + lane];
#pragma unroll
        for (int r = 0; r < 4; ++r) {
            const int lr = 4 * g + r; const size_t row = (size_t)MP + mg * 16 + lr; const size_t o = row * 1024 + nt * 64 + 16 * j + n;
            float q;
            if (MODE == 0) {
                bf16* HB = (bf16*)(F.ws + WS_HB);
                const float h0 = pre[r] + c[r];
                HB[o] = f2bf(h0); if (Yo) Yo[o] = h0;
                q = h0 * h0;
            } else {
                const float v0 = c[r] * pre[r]; ((bf16*)(F.ws + WS_QATT))[o] = f2bf(v0);
                q = v0 * v0;
            }
            q = xadd<1>(q); q = xadd<2>(q); q = xadd<4>(q); q = xadd<8>(q);
            if (n == 0) PART[lr * 4 + j] = q;
        }
    }
    __syncthreads();
    if (F.tid < 16) { const size_t row = (size_t)MP + mg * 16 + F.tid; float* dst = (MODE == 0) ? SS : (float*)(F.ws + WS_QSS);
        dst[row * 16 + nt] = (PART[F.tid * 4] + PART[F.tid * 4 + 1]) + (PART[F.tid * 4 + 2] + PART[F.tid * 4 + 3]); }
    __syncthreads();
}
constexpr int PH_PER_LAYER = 9, N_PHASES = 1 + DEPTH * PH_PER_LAYER;
#ifndef GDN_REP_PREP
#define GDN_REP_PREP 1
#endif
#ifndef GDN_REP_SCAN
#define GDN_REP_SCAN 1
#endif
#ifndef GDN_REP_O
#define GDN_REP_O 1
#endif
#ifndef GDN_REP_MID
#define GDN_REP_MID 1
#endif
#ifndef GDN_SPLIT_P
#define GDN_SPLIT_P 0
#endif
#ifndef GDN_SPLIT_O
#define GDN_SPLIT_O 0
#endif
#ifndef REP_MASK
#define REP_MASK 0
#endif
#ifndef REP_N
#define REP_N 2
#endif
#ifndef MIX_MASK
#define MIX_MASK 127
#endif
#ifndef PH_MASK
#define PH_MASK 1023
#endif
#ifndef MK_ONE_LAUNCH
#define MK_ONE_LAUNCH 1
#endif
#define LAUNDER_FRAME() do { unsigned long long w_ = (unsigned long long)A.ws, o_ = (unsigned long long)A.out, k_ = (unsigned long long)__builtin_amdgcn_kernarg_segment_ptr(); int t_ = threadIdx.x, b_ = blockIdx.x, g_ = gridDim.x; \
        asm volatile("" : "+s"(w_), "+s"(o_), "+s"(k_), "+s"(b_), "+s"(g_), "+v"(t_)); F.kp = (const CAS char*)k_; F.ws = (unsigned char*)(GAS unsigned char*)w_; F.out = (float*)(GAS float*)o_; \
        F.tid = t_; F.lane = t_ & 63; F.wave = __builtin_amdgcn_readfirstlane(t_ >> 6); F.bid = b_; F.G = g_; F.ctl = (unsigned*)(F.ws + WS_CTL); } while (0)
__global__ void __launch_bounds__(NWAVES * 64, 2) fwd(Args A) {
    extern __shared__ __attribute__((aligned(16))) unsigned char lds[];
    Frame F;
    F.lds = (LAS unsigned char*)lds;
    F.MISC = (volatile LAS unsigned*)(F.lds + MISC_OFF);
    F.tid = threadIdx.x; F.lane = F.tid & 63; F.wave = __builtin_amdgcn_readfirstlane(F.tid >> 6);
    F.G = gridDim.x; F.bid = blockIdx.x;
    F.out = A.out; F.ws = A.ws; F.ctl = (unsigned*)(A.ws + WS_CTL);
    for (int u = F.tid; u < (LDS_BYTES - LDSCTL_OFF) / 4; u += NWAVES * 64) ((LAS unsigned*)(F.lds + LDSCTL_OFF))[u] = 0u;
    __syncthreads();
    XcdBarrier bar; bar.bar = F.ctl + CW_BAR; bar.x = 0; bar.st = nullptr;
    const bool multi = (A.ph_hi - A.ph_lo) > 1;
    if (multi) bar = xcd_barrier_post(F.ctl + CW_BAR, F.MISC + 8);

    for (int ph = A.ph_lo; ph < A.ph_hi; ++ph) {
        if (ph == 0) { LAUNDER_FRAME(); if (PH_MASK & 1) p_prologue(F, A); }
        else {
            const int l = (ph - 1) / PH_PER_LAYER, kind = (ph - 1) % PH_PER_LAYER;
            const int reps = ((REP_MASK >> kind) & 1) ? REP_N : 1;
            for (int rep = 0; rep < reps; ++rep) {
            if (kind == 0 && (PH_MASK & 2)) {
                LAUNDER_FRAME(); bf16* HB = (bf16*)(F.ws + WS_HB); float* SS = (float*)(F.ws + WS_SS); unsigned char* wb = wbuf(F, l); const int gw = F.bid * NWAVES + F.wave, NGW = F.G * NWAVES; (void)HB; (void)SS; (void)wb; (void)gw; (void)NGW;
                pg8::Gemm gm{HB, (const bf16*)(wb + WB_WIN), M, NPROJ, 1024}; pg8::StaticOrder S; S.init(M, NPROJ, F.G, F.bid);
                pg8::EpiProj E{(bf16*)(F.ws + WS_BIG), NPROJ, SS, (float*)(F.ws + WS_AB), PC_AB / 256};
                pg8::gemm_phase<pg8::EpiProj, pg8::StaticOrder, true, true>(F.lds + RING_OFF, gm, S, E);
                if (l == 0) {
                    pg8::Gemm g2{(const bf16*)(F.ws + WS_MB), (const bf16*)(F.ws + WS_WMKV), 512, 8192, 1024}; pg8::StaticOrder S2; S2.init(512, 8192, F.G, F.G - 1 - F.bid);
                    pg8::EpiMemKV E2{F.out + O_PMK, F.out + O_PMV, (const float*)(F.ws + WS_RM), (float*)(F.ws + WS_KSS)};
                    pg8::gemm_phase<pg8::EpiMemKV, pg8::StaticOrder, true, true>(F.lds + RING_OFF, g2, S2, E2);
                }
            } else if (kind == 1 && (PH_MASK & 4)) {
                LAUNDER_FRAME(); bf16* HB = (bf16*)(F.ws + WS_HB); float* SS = (float*)(F.ws + WS_SS); unsigned char* wb = wbuf(F, l); const int gw = F.bid * NWAVES + F.wave, NGW = F.G * NWAVES; (void)HB; (void)SS; (void)wb; (void)gw; (void)NGW;
#define GDN_IDS() LAUNDER_FRAME(); const bool isscan = F.bid < 16; const int wi = F.bid - 16, NW = F.G - 16, gww = wi * NWAVES + F.wave, NGWW = NW * NWAVES; (void)isscan; (void)wi; (void)NW; (void)gww; (void)NGWW
                { GDN_IDS(); if (isscan) gdn_scan_prompt(F, A, l, F.bid, l * 2 + rep); }
                { GDN_IDS();
                  if (!isscan) { unsigned* pend = nullptr;
                    for (int j = wi; j < NITEM; j += NW) { const int it = gdn_item_of(j); const bool smp = j >= 1024; const int fl_ = l * 2 + rep;
                        gdn_prep_item(F, A, l, it, pend);
                        pend = smp ? nullptr : F.ctl + CW_READY + fl_ * 1024 + (((j >> 2) & 1) * 4 + (j & 3)) * 128 + (j >> 3); }
                    asm volatile("s_waitcnt vmcnt(0)" ::: "memory"); __syncthreads();
                    if (pend && F.tid == 0) __hip_atomic_store(pend, 1u, __ATOMIC_RELAXED, __HIP_MEMORY_SCOPE_AGENT); } }
                { GDN_IDS(); if (!isscan) for (int j = wi; j < NITEM; j += NW) if (j >= 1024) { gdn_sample_scan(F, A, l, j);
                        if (F.tid == 0) __hip_atomic_store(F.ctl + CW_SDONE + (l * 2 + rep) * 64 + (j - 1024), 1u, __ATOMIC_RELAXED, __HIP_MEMORY_SCOPE_AGENT); } }
                { const int fl = l * 2 + rep, Q1 = 0, Q2 = Q1 + 544, Q3 = Q2 + 260, Q4 = Q3 + ((l == 0 && rep == 0) ? 32 : 0), Q5 = Q4 + NITEM;
                  for (;;) {
                    LAUNDER_FRAME();
                    volatile LAS unsigned* qslot = F.MISC + 16;
                    if (F.tid == 0) *qslot = __hip_atomic_fetch_add(F.ctl + CW_QH + fl * 64, 1u, __ATOMIC_RELAXED, __HIP_MEMORY_SCOPE_AGENT);
                    __syncthreads();
                    const int q = __builtin_amdgcn_readfirstlane((int)*qslot);
                    __syncthreads();
                    if (q >= Q5) break;
                    if (q < Q2) swa_item(F, A, l, q - Q1);
                    else if (q < Q3) { const int r0 = (q - Q2) * 64 + F.wave;
#pragma unroll
                        for (int r = 0; r < 8; ++r) sc_row(F, A, l, r0 + 8 * r); }
                    else if (q < Q4) { const int r0 = (q - Q3) * 64 + F.wave; for (int r = 0; r < 8; ++r) memkv_fix_row(F, A, r0 + 8 * r); }
                    else { const int j = q - Q4, it = gdn_item_of(j); const bool smp = j >= 1024; const int c = j >> 3, b = (j >> 2) & 1, h = j & 3;
                        OPre opre; gdn_o_pre(F, A, it, smp ? MP + ((j - 1024) >> 2) * 16 : b * SEQ + c * 64, smp ? 16 : 64, h, opre);
                        if (F.wave == 0) {
                            unsigned spins = 0;
                            if (!smp) { const unsigned* prog = F.ctl + CW_PROG + ((fl * 8 + b * 4 + h) * 2) * 64;
                                while ((unsigned)__builtin_amdgcn_readfirstlane(__hip_atomic_load(prog, __ATOMIC_RELAXED, __HIP_MEMORY_SCOPE_AGENT)) < (unsigned)(c + 1) ||
                                       (unsigned)__builtin_amdgcn_readfirstlane(__hip_atomic_load(prog + 64, __ATOMIC_RELAXED, __HIP_MEMORY_SCOPE_AGENT)) < (unsigned)(c + 1)) { __builtin_amdgcn_s_sleep(8); if (++spins > (1u << 20)) break; } }
                            else { const unsigned* sd = F.ctl + CW_SDONE + fl * 64 + (j - 1024);
                                while ((unsigned)__builtin_amdgcn_readfirstlane(__hip_atomic_load(sd, __ATOMIC_RELAXED, __HIP_MEMORY_SCOPE_AGENT)) == 0u) { __builtin_amdgcn_s_sleep(8); if (++spins > (1u << 20)) break; } }
                            __builtin_amdgcn_fence(__ATOMIC_ACQUIRE, "agent"); asm volatile("s_waitcnt vmcnt(0)" ::: "memory"); }
                        __syncthreads();
                        gdn_o_item(F, A, l, it, smp ? MP + ((j - 1024) >> 2) * 16 : b * SEQ + c * 64, smp ? 16 : 64, h, opre); }
                  } }
            } else if ((kind == 2 || kind == 5 || kind == 8) && (PH_MASK & 32)) {
                LAUNDER_FRAME(); bf16* HB = (bf16*)(F.ws + WS_HB); float* SS = (float*)(F.ws + WS_SS); unsigned char* wb = wbuf(F, l); const int gw = F.bid * NWAVES + F.wave, NGW = F.G * NWAVES; (void)HB; (void)SS; (void)wb; (void)gw; (void)NGW;
                const bf16* Ain = (kind == 2) ? (const bf16*)(F.ws + WS_MIX) : (kind == 5) ? (const bf16*)(F.ws + WS_ATT) : (const bf16*)(F.ws + WS_GREG);
                const bf16* Bt = (const bf16*)(wb + ((kind == 2) ? WB_WO : (kind == 5) ? WB_WMO : WB_WDN));
                const int Kd = (kind == 8) ? DFF : 1024;
                pg8::Gemm gm{Ain, Bt, MP, 1024, Kd}; pg8::StaticOrder S; S.init(MP, 1024, F.G, F.bid);
                pg8::EpiResid E{(l == 0 && kind == 2) ? INP(I_XP) : nullptr, HB, (l == DEPTH - 1 && kind == 8) ? F.out : nullptr, SS};
                pg8::gemm_phase<pg8::EpiResid, pg8::StaticOrder, true, true>(F.lds + RING_OFF, gm, S, E);
                for (int it = F.G - 1 - F.bid; it < 256; it += F.G) skinny_item<0>(F, A, Ain + (size_t)MP * Kd, Bt, Kd, it, (l == 0 && kind == 2) ? INP(I_XS) : nullptr, (l == DEPTH - 1 && kind == 8) ? F.out : nullptr);
            } else if (kind == 3 && (PH_MASK & 64)) {
                LAUNDER_FRAME(); bf16* HB = (bf16*)(F.ws + WS_HB); float* SS = (float*)(F.ws + WS_SS); unsigned char* wb = wbuf(F, l); const int gw = F.bid * NWAVES + F.wave, NGW = F.G * NWAVES; (void)HB; (void)SS; (void)wb; (void)gw; (void)NGW;
                pg8::Gemm gm{HB, (const bf16*)(wb + WB_WMQ), MP, 1024, 1024}; pg8::StaticOrder S; S.init(MP, 1024, F.G, F.bid);
                pg8::EpiQ E{(bf16*)(F.ws + WS_QATT), SS, (float*)(F.ws + WS_QSS)};
                pg8::gemm_phase<pg8::EpiQ, pg8::StaticOrder, true, true>(F.lds + RING_OFF, gm, S, E);
                for (int it = F.G - 1 - F.bid; it < 256; it += F.G) skinny_item<1>(F, A, HB + (size_t)MP * 1024, (const bf16*)(wb + WB_WMQ), 1024, it, nullptr, nullptr);
            } else if (kind == 4 && (PH_MASK & 128)) {
                LAUNDER_FRAME(); bf16* HB = (bf16*)(F.ws + WS_HB); float* SS = (float*)(F.ws + WS_SS); unsigned char* wb = wbuf(F, l); const int gw = F.bid * NWAVES + F.wave, NGW = F.G * NWAVES; (void)HB; (void)SS; (void)wb; (void)gw; (void)NGW;
                { const int fl = l * 2 + rep, NCT = (l + 1 < DEPTH) ? (CI_LAYER + 31) / 32 : 0, Q1 = 64, Q2 = Q1 + 256, Q3 = Q2 + NCT;
                  for (;;) {
                    LAUNDER_FRAME();
                    volatile LAS unsigned* qslot = F.MISC + 16;
                    if (F.tid == 0) *qslot = __hip_atomic_fetch_add(F.ctl + CW_QH + (8 + fl) * 64, 1u, __ATOMIC_RELAXED, __HIP_MEMORY_SCOPE_AGENT);
                    __syncthreads();
                    const int q = __builtin_amdgcn_readfirstlane((int)*qslot);
                    __syncthreads();
                    if (q >= Q3) break;
                    if (q < Q1) xattn_sample_item(F, A, l, q);
                    else if (q < Q2) { const int it = q - Q1; xattn_prompt_item(F, A, l, it >> 2, it & 3); }
                    else { LAS float* scr = (LAS float*)(F.lds + RING_OFF + F.wave * 16384); const int base = (q - Q2) * 32 + F.wave * 4;
                           for (int k = 0; k < 4; ++k) if (base + k < CI_LAYER) conv_layer_item(F, A, l + 1, base + k, scr);
                           __syncthreads(); }
                  } }
            } else if (kind == 6 && (PH_MASK & 256)) {
                LAUNDER_FRAME(); bf16* HB = (bf16*)(F.ws + WS_HB); float* SS = (float*)(F.ws + WS_SS); unsigned char* wb = wbuf(F, l); const int gw = F.bid * NWAVES + F.wave, NGW = F.G * NWAVES; (void)HB; (void)SS; (void)wb; (void)gw; (void)NGW;
                pg8::Gemm gm{HB, (const bf16*)(wb + WB_WUP), M, NUP, 1024}; pg8::StaticOrder S; S.init(M, NUP, F.G, F.bid);
                pg8::EpiUp E{(bf16*)(F.ws + WS_GREG), (bf16*)(F.ws + WS_BIG), SS, INP(I_WFC) + (size_t)l * 3 * NUP, F.out + O_PFC + (size_t)l * 2 * 2 * NUP, F.out + O_SFC + (size_t)l * 16 * 2 * NUP};
                pg8::gemm_phase<pg8::EpiUp, pg8::StaticOrder, true, true>(F.lds + RING_OFF, gm, S, E);
            } else if (kind == 7 && (PH_MASK & 512)) {
                LAUNDER_FRAME(); bf16* HB = (bf16*)(F.ws + WS_HB); float* SS = (float*)(F.ws + WS_SS); unsigned char* wb = wbuf(F, l); const int gw = F.bid * NWAVES + F.wave, NGW = F.G * NWAVES; (void)HB; (void)SS; (void)wb; (void)gw; (void)NGW;
                const int NG = MP / 64 + MS / 16;
                const int NT = NG * (DFF / 8), gt = F.bid * (NWAVES * 64) + F.tid, GT = F.G * NWAVES * 64;
                for (int t = gt; t < NT; t += GT) { const int gi = t / (DFF / 8), chk = t - gi * (DFF / 8); const int run = (gi < MP / 64) ? gi * 4 : (MP / 16 + (gi - MP / 64)); convgate_task<2>(F, A, l, run, chk); }
            }
            }
        }
        if (ph + 1 < A.ph_hi) xcd_barrier(bar);
    }
}

extern "C" void kernel_launch(void* const* d_in, const int* in_sizes, int n_in, void* d_out, int out_size, void* d_ws, size_t ws_size, hipStream_t stream) {
    static int grid = 0;
    if (grid == 0) {
        if (n_in != N_IN || in_sizes[0] != MP * DM || (size_t)out_size != O_END || ws_size < WS_END) {
            fprintf(stderr, "kernel_launch: unexpected shapes: n_in %d in0 %d out %d ws %zu (need %zu); nothing launched\n", n_in, n_in > 0 ? in_sizes[0] : -1, out_size, ws_size, (size_t)WS_END); grid = -1; return; }
        int dev = 0, cus = 0, per_cu = 0;
        if (hipGetDevice(&dev) != hipSuccess || hipDeviceGetAttribute(&cus, hipDeviceAttributeMultiprocessorCount, dev) != hipSuccess) { grid = -1; return; }
        if (hipFuncSetAttribute((const void*)fwd, hipFuncAttributeMaxDynamicSharedMemorySize, LDS_BYTES) != hipSuccess) { fprintf(stderr, "kernel_launch: hipFuncSetAttribute failed\n"); grid = -1; return; }
        if (hipOccupancyMaxActiveBlocksPerMultiprocessor(&per_cu, (const void*)fwd, NWAVES * 64, LDS_BYTES) != hipSuccess || per_cu < 1) fprintf(stderr, "kernel_launch: occupancy query says %d\n", per_cu);
        (void)hipGetLastError();
        grid = cus;
    }
    if (grid < 0) return;
    (void)hipMemsetAsync((char*)d_ws + WS_CTL, 0, CTL_ZERO_BYTES, stream);
    Args a{};
    for (int i = 0; i < N_IN; ++i) a.in[i] = (const float*)d_in[i];
    a.out = (float*)d_out; a.ws = (unsigned char*)d_ws;
#if MK_ONE_LAUNCH
    a.ph_lo = 0; a.ph_hi = N_PHASES;
    hipLaunchKernelGGL(fwd, dim3(grid), dim3(NWAVES * 64), LDS_BYTES, stream, a);
#else
    for (int ph = 0; ph < N_PHASES; ++ph) { a.ph_lo = ph; a.ph_hi = ph + 1; hipLaunchKernelGGL(fwd, dim3(grid), dim3(NWAVES * 64), LDS_BYTES, stream, a); }
#endif
}
```

```cpp
#include <hip/hip_runtime.h>
#include <cstdio>
#include <cstdint>
template <int MSK> __device__ __forceinline__ float sw_xor(float v) { return __int_as_float(__builtin_amdgcn_ds_swizzle(__float_as_int(v), (MSK << 10) | 0x1f)); }
template <int MSK> __device__ __forceinline__ float xadd(float v) { return v + sw_xor<MSK>(v); }
template <int MSK> __device__ __forceinline__ float xmax(float v) { return fmaxf(v, sw_xor<MSK>(v)); }
__device__ __forceinline__ float xadd32(float v) { const auto rr = __builtin_amdgcn_permlane32_swap(__float_as_uint(v), __float_as_uint(v), false, false); return __uint_as_float(rr[0]) + __uint_as_float(rr[1]); }
__device__ __forceinline__ float xmax32(float v) { const auto rr = __builtin_amdgcn_permlane32_swap(__float_as_uint(v), __float_as_uint(v), false, false); return fmaxf(__uint_as_float(rr[0]), __uint_as_float(rr[1])); }
namespace pg8 {
#define PG8_LAS __attribute__((address_space(3)))
typedef unsigned short bf16_t;
typedef short bf16x8 __attribute__((ext_vector_type(8)));
typedef float f32x4 __attribute__((ext_vector_type(4)));
typedef unsigned u32x4 __attribute__((ext_vector_type(4)));
constexpr int BM = 256, BK = 64, HALF = 128, HTB = HALF * BK * 2  , STAGE_BYTES = 8 * HTB, NXCD = 8, WGM = 8;

__host__ __device__ __forceinline__ int lds_byte(int r, int c) { const int st = (r >> 4) * 2 + (c >> 5), rr = r & 15, cc = c & 31, ob = rr * 64 + cc * 2; return st * 1024 + (ob ^ (((ob >> 9) & 1) << 5)); }
__host__ __device__ __forceinline__ void stage_rc(int b, int& R, int& C) { const int st = b / 1024, sb = b % 1024, swz = sb ^ (((sb >> 9) & 1) << 5); R = (st >> 1) * 16 + swz / 64; C = (st & 1) * 32 + (swz % 64) / 2; }
__host__ __device__ __forceinline__ int perm32(int rho) { const int n = rho >> 4, i = rho & 15; return 8 * (i >> 2) + 4 * n + (i & 3); }

struct Unit { int pm, pn; };
struct Gemm { const bf16_t* A; const bf16_t* Bt; int M, N, K; };

struct StaticOrder {
    int nM, nN, nwg, G, c;
    __host__ __device__ void init(int M, int N, int G_, int c_) { nM = M / BM; nN = N / BM; nwg = nM * nN; G = G_; c = c_; }
    __host__ __device__ bool next(int i, Unit& u) const {
        const long L = (long)i * G + c; if (L >= nwg) return false;
        int wgid = (int)L; { const int q = nwg / NXCD, r = nwg % NXCD, xcd = wgid % NXCD, off = wgid / NXCD; wgid = (xcd < r ? xcd * (q + 1) : r * (q + 1) + (xcd - r) * q) + off; }
        const int nig = WGM * nN, gid = wgid / nig, fm = gid * WGM, gsz = (nM - fm) < WGM ? (nM - fm) : WGM;
        u.pm = fm + ((wgid % nig) % gsz); u.pn = (wgid % nig) / gsz; return true;
    }
    __device__ __forceinline__ void a_ready(const Unit&) const {}
    __device__ __forceinline__ void done(const Unit&) const {}
};

typedef unsigned u32x2 __attribute__((ext_vector_type(2)));
typedef float f32x2_t __attribute__((ext_vector_type(2))); typedef __bf16 bf16x2_t __attribute__((ext_vector_type(2)));
__device__ __forceinline__ unsigned cvt_pk_bf16(float lo, float hi) { f32x2_t v = {lo, hi}; bf16x2_t b = __builtin_convertvector(v, bf16x2_t); return __builtin_bit_cast(unsigned, b); }
__device__ __forceinline__ float row_scale16(const float* ss, int row, float inv_n) {
    const f32x4* p = (const f32x4*)(ss + (size_t)row * 16);
    const f32x4 a = p[0], b = p[1], c = p[2], d = p[3];
    const float s = (((a[0] + a[1]) + (a[2] + a[3])) + ((b[0] + b[1]) + (b[2] + b[3]))) + (((c[0] + c[1]) + (c[2] + c[3])) + ((d[0] + d[1]) + (d[2] + d[3])));
    return __builtin_amdgcn_rsqf(s * inv_n + 1e-6f);
}
__device__ __forceinline__ void row_scales8(const float* ss, int row0, int fq, float inv_n, float (&rs)[8]) {
    f32x4 v[8];
#pragma unroll
    for (int i = 0; i < 8; ++i) v[i] = *(const f32x4*)(ss + (size_t)(row0 + (i >> 2) * HALF + (i & 3) * 16) * 16 + 4 * fq);
#pragma unroll
    for (int i = 0; i < 8; ++i) { float s = (v[i][0] + v[i][1]) + (v[i][2] + v[i][3]); s = xadd<16>(s); s = xadd32(s); rs[i] = __builtin_amdgcn_rsqf(s * inv_n + 1e-6f); }
    asm volatile("" ::: "memory");
}
struct EpiProj {
    static constexpr bool PERM = true, AFTER_DRAIN = false;
    bf16_t* O; int ldc; const float* ss; float* AB; int ab_pn;
    __device__ __forceinline__ void operator()(const f32x4 (&acc)[2][2][4][2], const Unit& u, int wr, int wc, int fr, int fq) const {
        const int row0 = u.pm * BM + wr * 64 + fr, col0 = u.pn * BM + wc * 32 + 8 * fq;
        const bool abt = (u.pn == ab_pn) && (wc == 0) && (fq == 0);
        float rsv[8]; row_scales8(ss, row0, fq, 1.0f / 1024.0f, rsv);
#pragma unroll
        for (int ai = 0; ai < 2; ++ai)
#pragma unroll
            for (int m = 0; m < 4; ++m) { const int row = row0 + ai * HALF + m * 16; const float rs = rsv[ai * 4 + m];
                bf16_t* rowp = O + (size_t)row * ldc + col0;
#pragma unroll
                for (int bj = 0; bj < 2; ++bj) { const f32x4 v0 = acc[ai][bj][m][0] * rs, v1 = acc[ai][bj][m][1] * rs;
                    u32x4 w; w.x = cvt_pk_bf16(v0[0], v0[1]); w.y = cvt_pk_bf16(v0[2], v0[3]); w.z = cvt_pk_bf16(v1[0], v1[1]); w.w = cvt_pk_bf16(v1[2], v1[3]);
                    if (u.pn != ab_pn) *(u32x4*)(rowp + bj * HALF) = w;
                    if (bj == 0 && abt) { *(f32x4*)(AB + (size_t)row * 8) = v0; *(f32x4*)(AB + (size_t)row * 8 + 4) = v1; } }
                if (m & 1) asm volatile("" ::: "memory"); }
    }
};
struct EpiResid {
    static constexpr bool PERM = true, AFTER_DRAIN = false;
    const float* Hin; bf16_t* HB; float* Y; float* ss;
    __device__ __forceinline__ void operator()(const f32x4 (&acc)[2][2][4][2], const Unit& u, int wr, int wc, int fr, int fq) const {
        const int row0 = u.pm * BM + wr * 64 + fr, col0 = u.pn * BM + wc * 32 + 8 * fq;
#pragma unroll
        for (int ai = 0; ai < 2; ++ai)
#pragma unroll
            for (int m = 0; m < 4; ++m) { const int row = row0 + ai * HALF + m * 16; const size_t off = (size_t)row * 1024 + col0; float q = 0.f;
#pragma unroll
                for (int bj = 0; bj < 2; ++bj) { const size_t o = off + bj * HALF; f32x4 h0, h1;
                    if (Hin) { h0 = *(const f32x4*)(Hin + o); h1 = *(const f32x4*)(Hin + o + 4); }
                    else { const u32x4 p = *(const u32x4*)(HB + o);
                        h0 = (f32x4){__uint_as_float(p.x << 16), __uint_as_float(p.x & 0xffff0000u), __uint_as_float(p.y << 16), __uint_as_float(p.y & 0xffff0000u)};
                        h1 = (f32x4){__uint_as_float(p.z << 16), __uint_as_float(p.z & 0xffff0000u), __uint_as_float(p.w << 16), __uint_as_float(p.w & 0xffff0000u)}; }
                    h0 = h0 + acc[ai][bj][m][0]; h1 = h1 + acc[ai][bj][m][1];
                    u32x4 w; w.x = cvt_pk_bf16(h0[0], h0[1]); w.y = cvt_pk_bf16(h0[2], h0[3]); w.z = cvt_pk_bf16(h1[0], h1[1]); w.w = cvt_pk_bf16(h1[2], h1[3]);
                    if (Y) { *(f32x4*)(Y + o) = h0; *(f32x4*)(Y + o + 4) = h1; } else *(u32x4*)(HB + o) = w;
                    q += ((h0[0] * h0[0] + h0[1] * h0[1]) + (h0[2] * h0[2] + h0[3] * h0[3])) + ((h1[0] * h1[0] + h1[1] * h1[1]) + (h1[2] * h1[2] + h1[3] * h1[3])); }
                q = xadd<16>(q); q = xadd32(q);
                if (fq == 0 && !Y) ss[(size_t)row * 16 + u.pn * 4 + wc] = q;
                if (m == 3) asm volatile("" ::: "memory"); }
    }
};
struct EpiQ {
    static constexpr bool PERM = true, AFTER_DRAIN = false;
    bf16_t* O; const float* ss; float* qss;
    __device__ __forceinline__ void operator()(const f32x4 (&acc)[2][2][4][2], const Unit& u, int wr, int wc, int fr, int fq) const {
        const int row0 = u.pm * BM + wr * 64 + fr, col0 = u.pn * BM + wc * 32 + 8 * fq;
        float rsv[8]; row_scales8(ss, row0, fq, 1.0f / 1024.0f, rsv);
#pragma unroll
        for (int ai = 0; ai < 2; ++ai)
#pragma unroll
            for (int m = 0; m < 4; ++m) { const int row = row0 + ai * HALF + m * 16; const float rs = rsv[ai * 4 + m];
                bf16_t* rowp = O + (size_t)row * 1024 + col0; float q = 0.f;
#pragma unroll
                for (int bj = 0; bj < 2; ++bj) { const f32x4 v0 = acc[ai][bj][m][0] * rs, v1 = acc[ai][bj][m][1] * rs;
                    u32x4 w; w.x = cvt_pk_bf16(v0[0], v0[1]); w.y = cvt_pk_bf16(v0[2], v0[3]); w.z = cvt_pk_bf16(v1[0], v1[1]); w.w = cvt_pk_bf16(v1[2], v1[3]);
                    *(u32x4*)(rowp + bj * HALF) = w;
                    q += ((v0[0] * v0[0] + v0[1] * v0[1]) + (v0[2] * v0[2] + v0[3] * v0[3])) + ((v1[0] * v1[0] + v1[1] * v1[1]) + (v1[2] * v1[2] + v1[3] * v1[3])); }
                q = xadd<16>(q); q = xadd32(q);
                if (fq == 0) qss[(size_t)row * 16 + u.pn * 4 + wc] = q;
                if (m & 1) asm volatile("" ::: "memory"); }
    }
};
struct EpiUp {
    static constexpr bool PERM = true, AFTER_DRAIN = false;
    bf16_t* G; bf16_t* U; const float* ss; const float* wf; float* outp; int lyr;
    __device__ __forceinline__ void operator()(const f32x4 (&acc)[2][2][4][2], const Unit& u, int wr, int wc, int fr, int fq) const {
        const int row0 = u.pm * BM + wr * 64 + fr, c = u.pn * HALF + wc * 32 + 8 * fq;
        float wg[3][8], wv[3][8];
#pragma unroll
        for (int d = 0; d < 3; ++d) { const f32x4 a0 = *(const f32x4*)(wf + d * 5632 + c), a1 = *(const f32x4*)(wf + d * 5632 + c + 4), b0 = *(const f32x4*)(wf + d * 5632 + 2816 + c), b1 = *(const f32x4*)(wf + d * 5632 + 2816 + c + 4);
#pragma unroll
            for (int j = 0; j < 4; ++j) { wg[d][j] = a0[j]; wg[d][4 + j] = a1[j]; wv[d][j] = b0[j]; wv[d][4 + j] = b1[j]; } }
        float pg[8], pv[8];
#pragma unroll
        for (int j = 0; j < 8; ++j) { pg[j] = 0.f; pv[j] = 0.f; }
#pragma unroll
        for (int ai = 0; ai < 2; ++ai)
#pragma unroll
            for (int m = 0; m < 4; ++m) { const int row = row0 + ai * HALF + m * 16; const float rs = row_scale16(ss, row, 1.0f / 1024.0f);
                float ug[8], uv[8];
#pragma unroll
                for (int j = 0; j < 4; ++j) { ug[j] = acc[ai][0][m][0][j] * rs; ug[4 + j] = acc[ai][0][m][1][j] * rs; uv[j] = acc[ai][1][m][0][j] * rs; uv[4 + j] = acc[ai][1][m][1][j] * rs; }
                const bool smp_ = (u.pm == 64);
                if ((fr < 2 && (m == 0 || smp_)) || (fr >= 14 && (m == 3 || smp_))) { bf16_t* up = U + (size_t)row * 5632 + c;
                    u32x4 w; w.x = cvt_pk_bf16(ug[0], ug[1]); w.y = cvt_pk_bf16(ug[2], ug[3]); w.z = cvt_pk_bf16(ug[4], ug[5]); w.w = cvt_pk_bf16(ug[6], ug[7]); *(u32x4*)up = w;
                    w.x = cvt_pk_bf16(uv[0], uv[1]); w.y = cvt_pk_bf16(uv[2], uv[3]); w.z = cvt_pk_bf16(uv[4], uv[5]); w.w = cvt_pk_bf16(uv[6], uv[7]); *(u32x4*)(up + 2816) = w;
                    float* st = nullptr;
                    int ly_ = lyr; unsigned long long ob_ = (unsigned long long)outp; asm volatile("" : "+s"(ly_), "+s"(ob_)); float* op_ = (float*)ob_;
                    if (fr >= 14) { if (u.pm == 64) st = op_ + (size_t)26935296 + (size_t)ly_ * (16 * 2 * 5632) + ((size_t)((row - 16384) >> 4) * 2 + (fr - 14)) * 5632 + c;
                                    else if ((row & 8191) >= 8190) st = op_ + (size_t)22061056 + (size_t)ly_ * (2 * 2 * 5632) + ((size_t)(row >> 13) * 2 + (fr - 14)) * 5632 + c; }
                    if (st) { *(f32x4*)st = (f32x4){ug[0], ug[1], ug[2], ug[3]}; *(f32x4*)(st + 4) = (f32x4){ug[4], ug[5], ug[6], ug[7]};
                              *(f32x4*)(st + 2816) = (f32x4){uv[0], uv[1], uv[2], uv[3]}; *(f32x4*)(st + 2820) = (f32x4){uv[4], uv[5], uv[6], uv[7]}; } }
                float o[8];
#pragma unroll
                for (int j = 0; j < 8; ++j) {
                    const float zg1 = (fr == 15) ? pg[j] : ug[j], zg2 = (fr >= 14) ? pg[j] : ug[j], zv1 = (fr == 15) ? pv[j] : uv[j], zv2 = (fr >= 14) ? pv[j] : uv[j];
                    const float g1 = __int_as_float(__builtin_amdgcn_update_dpp(0, __float_as_int(zg1), 0x121, 0xf, 0xf, true)), g2 = __int_as_float(__builtin_amdgcn_update_dpp(0, __float_as_int(zg2), 0x122, 0xf, 0xf, true));
                    const float v1 = __int_as_float(__builtin_amdgcn_update_dpp(0, __float_as_int(zv1), 0x121, 0xf, 0xf, true)), v2 = __int_as_float(__builtin_amdgcn_update_dpp(0, __float_as_int(zv2), 0x122, 0xf, 0xf, true));
                    const float yg = (wg[0][j] * g2 + wg[1][j] * g1) + wg[2][j] * ug[j], yv = (wv[0][j] * v2 + wv[1][j] * v1) + wv[2][j] * uv[j];
                    o[j] = (yg * __builtin_amdgcn_rcpf(1.0f + __expf(-yg))) * yv; }
                if (fr >= 2 || (m > 0 && !smp_)) { u32x4 w; w.x = cvt_pk_bf16(o[0], o[1]); w.y = cvt_pk_bf16(o[2], o[3]); w.z = cvt_pk_bf16(o[4], o[5]); w.w = cvt_pk_bf16(o[6], o[7]); *(u32x4*)(G + (size_t)row * 2816 + c) = w; }
#pragma unroll
                for (int j = 0; j < 8; ++j) { pg[j] = ug[j]; pv[j] = uv[j]; }
                if (m == 3) asm volatile("" ::: "memory"); }
    }
};
struct EpiMemKV {
    static constexpr bool PERM = false, AFTER_DRAIN = false;
    float* outK; float* outV; const float* rm; float* kss;
    __device__ __forceinline__ void operator()(const f32x4 (&acc)[2][2][4][2], const Unit& u, int wr, int wc, int fr, int fq) const {
        const int row0 = u.pm * BM + wr * 64 + fr, l = u.pn >> 3, j = u.pn & 7, col0 = (j & 3) * 256 + wc * 32 + 4 * fq;
        float* dst = (j < 4) ? outK : outV;
#pragma unroll
        for (int ai = 0; ai < 2; ++ai)
#pragma unroll
            for (int m = 0; m < 4; ++m) { const int row = row0 + ai * HALF + m * 16; const float rs = rm[row]; const size_t off = ((size_t)l * 512 + row) * 1024 + col0; float q = 0.f;
#pragma unroll
                for (int bj = 0; bj < 2; ++bj)
#pragma unroll
                    for (int n = 0; n < 2; ++n) { const f32x4 v = acc[ai][bj][m][n] * rs; *(f32x4*)(dst + off + bj * HALF + n * 16) = v;
                        q += (v[0] * v[0] + v[1] * v[1]) + (v[2] * v[2] + v[3] * v[3]); }
                q = xadd<16>(q); q = xadd32(q);
                if (j < 4 && fq == 0) kss[((size_t)l * 512 + row) * 16 + j * 4 + wc] = q; }
    }
};

template <class Epi, class Sched, bool ALIGN_EPI = false, bool SP2 = false>
__device__ __forceinline__ void gemm_phase(PG8_LAS unsigned char* lds, const Gemm g, const Sched& S, const Epi& E) {
    int tid_ = threadIdx.x; asm volatile("" : "+v"(tid_));
    const int tid = tid_, wid = __builtin_amdgcn_readfirstlane(tid >> 6), lane = tid & 63, wr = wid >> 2, wc = wid & 3, fr = lane & 15, fq = lane >> 4;
    const int K = g.K, nt = K / BK;
    unsigned voffA[2], voffB[2];
#pragma unroll
    for (int i = 0; i < 2; ++i) { int R, C; stage_rc(tid * 16 + i * 8192, R, C); const int Rb = Epi::PERM ? ((R & ~31) + perm32(R & 31)) : R;
        voffA[i] = (unsigned)(R * K + C) * 2u; voffB[i] = (unsigned)(Rb * K + C) * 2u; }
    const size_t kstep = (size_t)(BK * 2);
    const size_t hstep = (size_t)HALF * K * 2;
    const size_t tstep = 2 * hstep;
    const unsigned ldsw = (unsigned)wid * 1024u;
    const int aoff = lds_byte(wr * 64 + fr, fq * 8), boff = lds_byte(wc * 32 + fr, fq * 8);
#define PG8_SA(b, h) (((b) * 2 + (h)) * HTB)
#define PG8_SB(b, h) ((4 + (b) * 2 + (h)) * HTB)
#define PG8_STAGE(bufoff, gbase, voff) do { _Pragma("unroll") for (int _i = 0; _i < 2; ++_i) \
        __builtin_amdgcn_global_load_lds((const unsigned*)((const char*)(gbase) + (voff)[_i]), (PG8_LAS unsigned*)(lds + (bufoff) + ldsw + _i * 8192), 16, 0, 0); } while (0)
#define PG8_LDA(dst, b, h) do { _Pragma("unroll") for (int m = 0; m < 4; ++m) _Pragma("unroll") for (int k = 0; k < 2; ++k) dst[m][k] = *(const PG8_LAS bf16x8*)(lds + PG8_SA(b, h) + aoff + m * 2048 + k * 1024); } while (0)
#define PG8_LDB(dst, b, h) do { _Pragma("unroll") for (int n = 0; n < 2; ++n) _Pragma("unroll") for (int k = 0; k < 2; ++k) dst[n][k] = *(const PG8_LAS bf16x8*)(lds + PG8_SB(b, h) + boff + n * 2048 + k * 1024); } while (0)
#define PG8_MMA(ai, bj, At, Bt) do { __builtin_amdgcn_s_setprio(1); _Pragma("unroll") for (int m = 0; m < 4; ++m) _Pragma("unroll") for (int n = 0; n < 2; ++n) _Pragma("unroll") for (int k = 0; k < 2; ++k) \
        acc[ai][bj][m][n] = __builtin_amdgcn_mfma_f32_16x16x32_bf16(Bt[n][k], At[m][k], acc[ai][bj][m][n], 0, 0, 0); __builtin_amdgcn_s_setprio(0); } while (0)
#define PG8_WAIT_V(n) asm volatile("s_waitcnt vmcnt(" #n ")" ::: "memory")
#define PG8_WAIT_L(n) asm volatile("s_waitcnt lgkmcnt(" #n ")" ::: "memory")
#define PG8_BAR __builtin_amdgcn_s_barrier()
#define PG8_SCHED __builtin_amdgcn_sched_barrier(0)
    Unit cur, nxt; int ui = 0;
    if (!S.next(0, cur)) return;
    f32x4 acc[2][2][4][2];
#pragma unroll
    for (int a = 0; a < 2; ++a)
#pragma unroll
        for (int b = 0; b < 2; ++b)
#pragma unroll
            for (int m = 0; m < 4; ++m)
#pragma unroll
                for (int n = 0; n < 2; ++n) acc[a][b][m][n] = (f32x4){0.f, 0.f, 0.f, 0.f};
    bf16x8 At[4][2], B0[2][2], B1[2][2];
    const char* cA = (const char*)g.A + (size_t)cur.pm * tstep; const char* cB = (const char*)g.Bt + (size_t)cur.pn * tstep;
    S.a_ready(cur);
    if constexpr (SP2) {
        PG8_STAGE(PG8_SB(0, 0), cB, voffB); PG8_STAGE(PG8_SB(0, 1), cB + hstep, voffB); PG8_STAGE(PG8_SA(0, 0), cA, voffA); PG8_STAGE(PG8_SA(0, 1), cA + hstep, voffA);
        if (wr == 1) PG8_BAR;
        PG8_WAIT_V(2); PG8_BAR;
        PG8_STAGE(PG8_SB(1, 0), cB + kstep, voffB); PG8_STAGE(PG8_SA(1, 0), cA + kstep, voffA); PG8_STAGE(PG8_SB(1, 1), cB + hstep + kstep, voffB);
        PG8_WAIT_V(6); PG8_BAR;
    } else {
        PG8_STAGE(PG8_SB(0, 0), cB, voffB); PG8_STAGE(PG8_SA(0, 0), cA, voffA); PG8_STAGE(PG8_SB(0, 1), cB + hstep, voffB); PG8_STAGE(PG8_SA(0, 1), cA + hstep, voffA);
        if (wr == 1) PG8_BAR;
        PG8_WAIT_V(4); PG8_BAR;
        PG8_STAGE(PG8_SB(1, 0), cB + kstep, voffB); PG8_STAGE(PG8_SA(1, 0), cA + kstep, voffA); PG8_STAGE(PG8_SB(1, 1), cB + hstep + kstep, voffB);
        PG8_WAIT_V(6); PG8_BAR;
    }
    for (;;) {
        const bool has_next = S.next(ui + 1, nxt);
        const char* nA = has_next ? (const char*)g.A + (size_t)nxt.pm * tstep : cA; const char* nB = has_next ? (const char*)g.Bt + (size_t)nxt.pn * tstep : cB;
        for (int t = 0; t < nt; t += 2) {
            const bool last = (t == nt - 2);
            const char* a1 = cA + (size_t)(t + 1) * kstep;
            const char* a2 = last ? nA : cA + (size_t)(t + 2) * kstep; const char* b2 = last ? nB : cB + (size_t)(t + 2) * kstep;
            const char* a3 = a2 + kstep; const char* b3 = b2 + kstep;
            if (last && has_next) S.a_ready(nxt);
            if constexpr (SP2) {
            PG8_LDB(B0, 0, 0); PG8_LDB(B1, 0, 1); PG8_SCHED; PG8_LDA(At, 0, 0); PG8_STAGE(PG8_SA(1, 1), a1 + hstep, voffA);
            PG8_WAIT_V(8); PG8_WAIT_L(0); PG8_BAR; PG8_MMA(0, 0, At, B0); PG8_MMA(0, 1, At, B1); PG8_BAR; PG8_SCHED;
            PG8_LDA(At, 0, 1); PG8_STAGE(PG8_SB(0, 0), b2, voffB); PG8_STAGE(PG8_SB(0, 1), b2 + hstep, voffB); PG8_STAGE(PG8_SA(0, 0), a2, voffA);
            PG8_WAIT_V(8); PG8_WAIT_L(0); PG8_BAR; PG8_MMA(1, 0, At, B0); PG8_MMA(1, 1, At, B1); PG8_BAR; PG8_SCHED;
            PG8_LDB(B0, 1, 0); PG8_LDB(B1, 1, 1); PG8_SCHED; PG8_LDA(At, 1, 0); PG8_STAGE(PG8_SA(0, 1), a2 + hstep, voffA);
            PG8_WAIT_V(8); PG8_WAIT_L(0); PG8_BAR; PG8_MMA(0, 0, At, B0); PG8_MMA(0, 1, At, B1); PG8_BAR; PG8_SCHED;
            PG8_LDA(At, 1, 1); PG8_STAGE(PG8_SB(1, 0), b3, voffB); PG8_STAGE(PG8_SB(1, 1), b3 + hstep, voffB); PG8_STAGE(PG8_SA(1, 0), a3, voffA);
            PG8_WAIT_V(8); PG8_WAIT_L(0); PG8_BAR; PG8_MMA(1, 0, At, B0); PG8_MMA(1, 1, At, B1); PG8_BAR; PG8_SCHED;
            } else {
            PG8_LDB(B0, 0, 0); PG8_SCHED; PG8_LDA(At, 0, 0); PG8_STAGE(PG8_SA(1, 1), a1 + hstep, voffA);
            PG8_WAIT_L(8); PG8_BAR; PG8_WAIT_L(0); PG8_MMA(0, 0, At, B0); PG8_BAR; PG8_SCHED;
            PG8_LDB(B1, 0, 1); PG8_STAGE(PG8_SB(0, 0), b2, voffB);
            PG8_BAR; PG8_WAIT_L(0); PG8_MMA(0, 1, At, B1); PG8_BAR;
            PG8_LDA(At, 0, 1); PG8_STAGE(PG8_SA(0, 0), a2, voffA);
            PG8_BAR; PG8_WAIT_L(0); PG8_MMA(1, 0, At, B0); PG8_BAR; PG8_SCHED;
            PG8_STAGE(PG8_SB(0, 1), b2 + hstep, voffB);
            PG8_WAIT_V(6); PG8_BAR; PG8_MMA(1, 1, At, B1); PG8_BAR;
            PG8_LDB(B0, 1, 0); PG8_SCHED; PG8_LDA(At, 1, 0); PG8_STAGE(PG8_SA(0, 1), a2 + hstep, voffA);
            PG8_WAIT_L(8); PG8_BAR; PG8_WAIT_L(0); PG8_MMA(0, 0, At, B0); PG8_BAR; PG8_SCHED;
            PG8_LDB(B1, 1, 1); PG8_STAGE(PG8_SB(1, 0), b3, voffB);
            PG8_BAR; PG8_WAIT_L(0); PG8_MMA(0, 1, At, B1); PG8_BAR;
            PG8_LDA(At, 1, 1); PG8_STAGE(PG8_SA(1, 0), a3, voffA);
            PG8_BAR; PG8_WAIT_L(0); PG8_MMA(1, 0, At, B0); PG8_BAR; PG8_SCHED;
            PG8_STAGE(PG8_SB(1, 1), b3 + hstep, voffB);
            PG8_WAIT_V(6); PG8_BAR; PG8_MMA(1, 1, At, B1); PG8_BAR;
            }
        }
        if constexpr (ALIGN_EPI) { if (wr == 0) PG8_BAR; }
        if constexpr (!Epi::AFTER_DRAIN) { E(acc, cur, wr, wc, fr, fq); S.done(cur); }
        if (!has_next) break;
#pragma unroll
        for (int a = 0; a < 2; ++a)
#pragma unroll
            for (int b = 0; b < 2; ++b)
#pragma unroll
                for (int m = 0; m < 4; ++m)
#pragma unroll
                    for (int n = 0; n < 2; ++n) acc[a][b][m][n] = (f32x4){0.f, 0.f, 0.f, 0.f};
        cur = nxt; cA = nA; cB = nB; ++ui;
        if constexpr (ALIGN_EPI) { if (wr == 1) PG8_BAR; }
    }
    PG8_WAIT_V(0);
    if constexpr (!ALIGN_EPI) { if (wr == 0) PG8_BAR; }
    PG8_BAR;
    if constexpr (Epi::AFTER_DRAIN) { E.fused(acc, cur, wr, wc, fr, fq, lds, wid, lane); S.done(cur); }
#undef PG8_SA
#undef PG8_SB
#undef PG8_STAGE
#undef PG8_LDA
#undef PG8_LDB
#undef PG8_MMA
#undef PG8_WAIT_V
#undef PG8_WAIT_L
#undef PG8_BAR
#undef PG8_SCHED
}
}
constexpr int NWAVES = 8;
constexpr int DM = 1024, BATCH = 2, SEQ = 8192, DEPTH = 4, DECB = 16, DECS = 16;
constexpr int MP = BATCH * SEQ, MS = DECB * DECS, M = MP + MS;
constexpr int NPROJ = 3584, DFF = 2816, NUP = 2 * DFF;
constexpr int PC_Z = 1536, PC_SQ = 2048, PC_SK = 2304, PC_SV = 2432, PC_SCB = 2560, PC_SCC = 2816, PC_SCH = 3072, PC_AB = 3328;
constexpr float EPS = 1e-6f;
enum { I_XP = 0, I_XS, I_MEM, I_SGDN, I_SGCONV, I_CSK, I_CSV, I_SSC, I_CMK, I_CMV, I_SFFN, I_NMIX, I_WIN, I_WGCONV, I_ALOG, I_DTB, I_GNG, I_SQG, I_SKG, I_SINK,
       I_WSC, I_WO, I_NMEM, I_NMIN, I_WMQ, I_WMK, I_WMV, I_MQG, I_MKG, I_WMO, I_NFFN, I_WUP, I_WFC, I_WDN, N_IN };
static_assert(true, ""); constexpr size_t O_Y = 0, O_PSG = 17039360, O_PGC = 17563648, O_PSK = 17600512, O_PSV = 17731584, O_PSC = 17862656, O_PMK = 17866752, O_PMV = 19963904, O_PFC = 22061056,
                 O_SSG = 22151168, O_SGC = 26345472, O_SSK = 26640384, O_SSV = 26771456, O_SSC = 26902528, O_SFC = 26935296, O_END = 27656192;

constexpr size_t MiB = 1u << 20;
constexpr size_t WS_CTL = 0, CTL_ZERO_BYTES = 1 * MiB;
constexpr size_t WS_WB0 = 2 * MiB, WS_WB1 = 32 * MiB;
constexpr size_t WB_WIN = 0, WB_WO = 7 * MiB, WB_WMQ = 9 * MiB, WB_WMO = 11 * MiB, WB_WUP = 13 * MiB, WB_WDN = 24 * MiB;
constexpr size_t WS_HB = 62 * MiB;
constexpr size_t WS_BIG = 96 * MiB;
constexpr size_t WS_WMKV = WS_BIG + 120 * MiB;
constexpr size_t WS_GREG = 275 * MiB;
constexpr size_t WS_MIX = WS_GREG, WS_QATT = WS_GREG + 33 * MiB, WS_OBUF = WS_GREG + 66 * MiB;
constexpr size_t WS_GDN = 365 * MiB;
constexpr int NITEM = 1088;
constexpr size_t WS_WKN = WS_GDN, WS_QG = WS_GDN + 17 * MiB, WS_KDT = WS_GDN + 34 * MiB, WS_U0L = WS_GDN + 51 * MiB, WS_QKM = WS_GDN + 68 * MiB, WS_GL = WS_GDN + 77 * MiB;
constexpr size_t WS_ATT = WS_GDN;
constexpr size_t WS_MEMK = 443 * MiB, WS_MEMVT = 447 * MiB;
constexpr size_t WS_MB = 451 * MiB;
constexpr size_t WS_SS = 452 * MiB, WS_QSS = 454 * MiB;
constexpr size_t WS_AB = 456 * MiB;
constexpr size_t WS_KSS = 457 * MiB;
constexpr size_t WS_RM = WS_KSS + 256 * 1024;
constexpr size_t WS_END = 458 * MiB;
static_assert((size_t)NITEM * 16384 <= 17 * MiB && (size_t)NITEM * 8192 <= 9 * MiB, "gdn operand buffers");
static_assert((size_t)M * NUP * 2 <= WS_GREG - WS_BIG && (size_t)M * DFF * 2 <= WS_GDN - WS_GREG && (size_t)M * NPROJ * 2 <= 120 * MiB, "ws map");
constexpr int CW_BAR = 4096;

constexpr int RING_OFF = 0, RING_BYTES = 131072;
constexpr int LDSCTL_OFF = 143360, MISC_OFF = LDSCTL_OFF + 320;
constexpr int LDS_BYTES = 147456;

#define GAS __attribute__((address_space(1)))
#define LAS __attribute__((address_space(3)))
typedef unsigned short bf16;
typedef unsigned v4u __attribute__((ext_vector_type(4)));
typedef unsigned v2u __attribute__((ext_vector_type(2)));
typedef float f32x4 __attribute__((ext_vector_type(4)));
typedef short bf16x8 __attribute__((ext_vector_type(8)));
#define LDS_WAIT() asm volatile("s_waitcnt lgkmcnt(0)" ::: "memory")
#define VM_WAIT() asm volatile("s_waitcnt vmcnt(0)" ::: "memory")
__device__ __forceinline__ unsigned pk2(float lo, float hi) { return pg8::cvt_pk_bf16(lo, hi); }
__device__ __forceinline__ bf16 f2bf(float f) { return (bf16)(pk2(f, 0.f) & 0xffffu); }
__device__ __forceinline__ float bf2f(bf16 b) { return __uint_as_float((unsigned)b << 16); }
__device__ __forceinline__ float bflo(unsigned w) { return __uint_as_float(w << 16); }
__device__ __forceinline__ float bfhi(unsigned w) { return __uint_as_float(w & 0xffff0000u); }
__device__ __forceinline__ float silu_f(float y) { return y * __builtin_amdgcn_rcpf(1.0f + __expf(-y)); }
__device__ __forceinline__ bf16x8 mk8(unsigned a, unsigned b, unsigned c, unsigned d) { v4u t; t.x = a; t.y = b; t.z = c; t.w = d; return __builtin_bit_cast(bf16x8, t); }
template <class T> __device__ __forceinline__ T* launder_g(T* p) { unsigned long long v = (unsigned long long)p; asm volatile("" : "+v"(v)); return (T*)(GAS T*)v; }
typedef unsigned long long u64;
__device__ __forceinline__ void st_wt16(void* p, bf16x8 v) {
    const v4u t = __builtin_bit_cast(v4u, v);
    asm volatile("global_store_dwordx4 %0, %1, off sc1\n\ts_nop 1" :: "v"((GAS unsigned char*)p), "v"(t) : "memory");
}
__device__ __forceinline__ f32x4 mfma16(bf16x8 a, bf16x8 b, f32x4 c) { return __builtin_amdgcn_mfma_f32_16x16x32_bf16(a, b, c, 0, 0, 0); }
struct Args { const float* in[N_IN]; float* out; unsigned char* ws; int ph_lo, ph_hi; };
#define FA Frame& F, const Args& A
#define CAS __attribute__((address_space(4)))
#define INP(k) (*(const float* const CAS*)(F.kp + 8 * (k)))
#define XB_TMO      128
#define XB_XCNT(j)  (256  + 64 * (j))
#define XB_XSUB(j)  (1280 + 64 * (j))
#define XB_XGEN(j)  (2304 + 64 * (j))
#define XB_TOP      3328
#define XB_TOPGEN   3392
#define XCD_BAR_WORDS 3456
#define XB_SPIN_CAP (1u << 21)

__device__ __forceinline__ unsigned xb_ld(unsigned* p)              { return __hip_atomic_load(p, __ATOMIC_RELAXED, __HIP_MEMORY_SCOPE_AGENT); }
__device__ __forceinline__ unsigned xb_add(unsigned* p, unsigned v) { return __hip_atomic_fetch_add(p, v, __ATOMIC_RELAXED, __HIP_MEMORY_SCOPE_AGENT); }
__device__ __forceinline__ unsigned xb_xcc_id() { return (unsigned)__builtin_amdgcn_s_getreg((3 << 11) | 20) & 0xFu; }
#define XB_SPIN(cond, bar) do { unsigned _sp = 0; while (cond) { __builtin_amdgcn_s_sleep(1); \
    if ((++_sp & 255u) == 0u) { if (xb_ld(&(bar)[XB_TMO])) break; if (_sp > XB_SPIN_CAP) { atomicAdd(&(bar)[XB_TMO], 1u); break; } } } } while (0)

struct XcdBarrier {
    unsigned* bar; unsigned x;
    volatile LAS unsigned* st;
};

__device__ __forceinline__ XcdBarrier xcd_barrier_post(unsigned* bar, volatile LAS unsigned* st) {
    XcdBarrier b; b.bar = bar; b.x = xb_xcc_id(); b.st = st;
    if (threadIdx.x == 0) (void)xb_add(&bar[XB_XCNT(b.x)], 1u);
    return b;
}
__device__ __forceinline__ void xcd_barrier_complete(unsigned* bar, unsigned x, unsigned& nloc, unsigned& nx) {
    const unsigned G = gridDim.x * gridDim.y * gridDim.z;
    unsigned sum, cnt, mine, sp = 0u;
    for (;;) {
        sum = 0u; cnt = 0u; mine = 0u;
#pragma unroll
        for (unsigned j = 0; j < 16; ++j) { const unsigned c = xb_ld(&bar[XB_XCNT(j)]); sum += c; cnt += (c > 0u) ? 1u : 0u; mine = (j == x) ? c : mine; }
        if (sum == G) break;
        __builtin_amdgcn_s_sleep(1);
        if ((++sp & 255u) == 0u) { if (xb_ld(&bar[XB_TMO])) break; if (sp > XB_SPIN_CAP) { atomicAdd(&bar[XB_TMO], 1u); break; } }
    }
    nloc = mine > 0u ? mine : 1u; nx = cnt > 0u ? cnt : 1u;
}

__device__ __forceinline__ void xcd_barrier(const XcdBarrier& b) {
    asm volatile("s_waitcnt vmcnt(0)" ::: "memory");
    __syncthreads();
    if (threadIdx.x == 0) {
        unsigned* bar = b.bar;
        __builtin_amdgcn_s_waitcnt(0);
        unsigned nloc = b.st[0], nx = b.st[1];
        if (nloc == 0u) { xcd_barrier_complete(bar, b.x, nloc, nx); b.st[0] = nloc; b.st[1] = nx; }
        const unsigned old = xb_add(&bar[XB_XSUB(b.x)], 1u);
        const unsigned gen = old / nloc;
        if (old + 1u == (gen + 1u) * nloc) {
            __builtin_amdgcn_fence(__ATOMIC_RELEASE, "agent");
            asm volatile("s_waitcnt vmcnt(0)" ::: "memory");
            const unsigned og = xb_add(&bar[XB_TOP], 1u);
            const unsigned tg = og / nx;
            if (og + 1u == (tg + 1u) * nx) xb_add(&bar[XB_TOPGEN], 1u);
            else XB_SPIN(xb_ld(&bar[XB_TOPGEN]) == tg, bar);
            __builtin_amdgcn_fence(__ATOMIC_ACQUIRE, "agent");
            xb_add(&bar[XB_XGEN(b.x)], 1u);
            asm volatile("s_waitcnt vmcnt(0)" ::: "memory");
        } else {
            XB_SPIN(xb_ld(&bar[XB_XGEN(b.x)]) == gen, bar);
            __builtin_amdgcn_fence(__ATOMIC_ACQUIRE, "agent");
            asm volatile("s_waitcnt vmcnt(0)" ::: "memory");
        }
    }
    __syncthreads();
}
struct Frame {
    LAS unsigned char* lds;
    volatile LAS unsigned* MISC;
    unsigned* ctl;
    int tid, lane, wave;
    int G, bid;

    float* out; unsigned char* ws;
    const __attribute__((address_space(4))) char* kp;
};

__device__ __forceinline__ float wave_sum(float v) {
    v = xadd<1>(v); v = xadd<2>(v); v = xadd<4>(v); v = xadd<8>(v); v = xadd<16>(v); v = xadd32(v);
    return v;
}
__device__ __forceinline__ unsigned char* wbuf(Frame& F, int l) { return F.ws + ((l & 1) ? WS_WB1 : WS_WB0); }

__device__ __forceinline__ void conv_item(const float* W, int N, int K, bf16* WT, const float* gain, int colmode, int nblk, LAS float* scr, int item, int lane) {
    const int kb = item / nblk, nb = item - kb * nblk, k0 = 64 * kb, n0 = 32 * nb;
    const int nd = n0 + (lane & 31);
    int ns = nd;
    if (colmode == 1) ns = (nd < 2048) ? nd : ((nd < 3328) ? nd + 8 : ((nd < 3336) ? nd - 1280 : -1));
    if (colmode == 2) { const int pn_ = nd >> 8, wi_ = nd & 255; ns = (wi_ < 128) ? (128 * pn_ + wi_) : (2816 + 128 * pn_ + (wi_ - 128)); }
    float wv_[32];
    const float* wp_ = W + (size_t)(k0 + (lane >> 5)) * N + (ns >= 0 ? ns : 0);
#pragma unroll
    for (int i = 0; i < 32; ++i) wv_[i] = (ns >= 0) ? wp_[(size_t)(2 * i) * N] : 0.f;
#pragma unroll
    for (int i = 0; i < 32; ++i) { const int kk = 2 * i + (lane >> 5); float v = wv_[i]; if (gain) v *= gain[k0 + kk]; scr[kk * 33 + (lane & 31)] = v; }
    LDS_WAIT(); asm volatile("" ::: "memory");
    const int c = lane & 7;
#pragma unroll
    for (int j = 0; j < 4; ++j) { const int n = (lane >> 3) + 8 * j; const LAS float* s = scr + (8 * c) * 33 + n;
        v4u o; o.x = pk2(s[0 * 33], s[1 * 33]); o.y = pk2(s[2 * 33], s[3 * 33]); o.z = pk2(s[4 * 33], s[5 * 33]); o.w = pk2(s[6 * 33], s[7 * 33]);
        *(v4u*)(WT + (size_t)(n0 + n) * K + k0 + 8 * c) = o; }
    LDS_WAIT(); asm volatile("" ::: "memory");
}
constexpr int CI_WIN = 16 * 112, CI_SQ = 16 * 32, CI_WUP = 16 * 176, CI_WDN = 44 * 32, CI_LAYER = CI_WIN + 3 * CI_SQ + CI_WUP + CI_WDN;
__device__ __forceinline__ void conv_layer_item(FA, int l, int r, LAS float* scr) {
    unsigned char* wb = wbuf(F, l);
    if (r < CI_WIN) { conv_item(INP(I_WIN) + (size_t)l * 1024 * 3336, 3336, 1024, (bf16*)(wb + WB_WIN), INP(I_NMIX) + l * 1024, 1, 112, scr, r, F.lane); return; } r -= CI_WIN;
    if (r < CI_SQ) { conv_item(INP(I_WO) + (size_t)l * 1024 * 1024, 1024, 1024, (bf16*)(wb + WB_WO), nullptr, 0, 32, scr, r, F.lane); return; } r -= CI_SQ;
    if (r < CI_SQ) { conv_item(INP(I_WMQ) + (size_t)l * 1024 * 1024, 1024, 1024, (bf16*)(wb + WB_WMQ), INP(I_NMEM) + l * 1024, 0, 32, scr, r, F.lane); return; } r -= CI_SQ;
    if (r < CI_SQ) { conv_item(INP(I_WMO) + (size_t)l * 1024 * 1024, 1024, 1024, (bf16*)(wb + WB_WMO), nullptr, 0, 32, scr, r, F.lane); return; } r -= CI_SQ;
    if (r < CI_WUP) { conv_item(INP(I_WUP) + (size_t)l * 1024 * 5632, 5632, 1024, (bf16*)(wb + WB_WUP), INP(I_NFFN) + l * 1024, 2, 176, scr, r, F.lane); return; } r -= CI_WUP;
    conv_item(INP(I_WDN) + (size_t)l * 2816 * 1024, 1024, 2816, (bf16*)(wb + WB_WDN), nullptr, 0, 32, scr, r, F.lane);
}

__device__ __forceinline__ void p_prologue(FA) {
    LAS float* scr = (LAS float*)(F.lds + RING_OFF + F.wave * 16384);
    const int gw = F.bid * NWAVES + F.wave, NGW = F.G * NWAVES;
    for (int it = gw; it < CI_WIN + 8 * CI_SQ; it += NGW) {
        if (it < CI_WIN) { conv_layer_item(F, A, 0, it, scr); continue; }
        const int r = it - CI_WIN, mat = r / CI_SQ, item = r - mat * CI_SQ, l = mat >> 1;
        const float* W = ((mat & 1) ? INP(I_WMV) : INP(I_WMK)) + (size_t)l * 1024 * 1024;
        conv_item(W, 1024, 1024, (bf16*)(F.ws + WS_WMKV) + (size_t)mat * 1024 * 1024, INP(I_NMIN) + l * 1024, 0, 32, scr, item, F.lane);
    }
    bf16* HB = (bf16*)(F.ws + WS_HB); float* SS = (float*)(F.ws + WS_SS);
    for (int m = gw; m < M + 512; m += NGW) {
        const bool ismem = m >= M; const int r = ismem ? m - M : m;
        const float* src = ismem ? INP(I_MEM) + (size_t)r * 1024 : (r < MP ? INP(I_XP) + (size_t)r * 1024 : INP(I_XS) + (size_t)(r - MP) * 1024);
        const f32x4* xr = (const f32x4*)src + F.lane;
        f32x4 v[4]; float s = 0.f;
#pragma unroll
        for (int j = 0; j < 4; ++j) { v[j] = xr[64 * j]; s += (v[j].x * v[j].x + v[j].y * v[j].y) + (v[j].z * v[j].z + v[j].w * v[j].w); }
        s = wave_sum(s);
        bf16* brow = ismem ? (bf16*)(F.ws + WS_MB) + (size_t)r * 1024 : HB + (size_t)r * 1024;
#pragma unroll
        for (int j = 0; j < 4; ++j) { v2u w; w.x = pk2(v[j].x, v[j].y); w.y = pk2(v[j].z, v[j].w); *((v2u*)brow + F.lane + 64 * j) = w;
            }
        if (ismem) { if (F.lane == 0) ((float*)(F.ws + WS_RM))[r] = 1.0f / sqrtf(s * (1.0f / 1024.0f) + EPS); }
        else if (F.lane < 16) SS[(size_t)r * 16 + F.lane] = (F.lane == 0) ? s : 0.f;
    }
}

__device__ __forceinline__ void memkv_fix_row(FA, int t) {
    const int l = t >> 9, row = t & 511, b = row >> 8, key = row & 255, lane = F.lane, head = lane >> 4;
    float* kb = F.out + O_PMK + ((size_t)l * 512 + row) * 1024 + lane * 16;
    const float* vb = F.out + O_PMV + ((size_t)l * 512 + row) * 1024 + lane * 16;
    const float* kss = (const float*)(F.ws + WS_KSS) + ((size_t)l * 512 + row) * 16 + head * 4;
    const f32x4 q = *(const f32x4*)kss;
    const float rk = 1.0f / sqrtf(((q[0] + q[1]) + (q[2] + q[3])) * (1.0f / 256.0f) + EPS);
    const float* g = INP(I_MKG) + l * 256 + (lane & 15) * 16;
    bf16* mk = (bf16*)(F.ws + WS_MEMK) + ((size_t)l * 512 + row) * 1024 + lane * 16;
    const int keyp = (key & ~31) | (((key >> 2) & 3) << 3) | (((key >> 4) & 1) << 2) | (key & 3);
    bf16* mvt = (bf16*)(F.ws + WS_MEMVT) + ((size_t)((l * 2 + b) * 4 + head) * 256 + (lane & 15) * 16) * 256 + keyp;
#pragma unroll
    for (int j = 0; j < 4; ++j) {
        f32x4 k = *(const f32x4*)(kb + 4 * j); const f32x4 gg = *(const f32x4*)(g + 4 * j);
        k = k * rk * gg; *(f32x4*)(kb + 4 * j) = k;
        v2u w; w.x = pk2(k[0], k[1]); w.y = pk2(k[2], k[3]); *(v2u*)(mk + 4 * j) = w;
        const f32x4 v = *(const f32x4*)(vb + 4 * j);
        mvt[(size_t)(4 * j + 0) * 256] = f2bf(v[0]); mvt[(size_t)(4 * j + 1) * 256] = f2bf(v[1]); mvt[(size_t)(4 * j + 2) * 256] = f2bf(v[2]); mvt[(size_t)(4 * j + 3) * 256] = f2bf(v[3]);
    }
}
constexpr int GP_QL = 0, GP_KL = 17408, GP_LM = 34816, GP_XT = 0  , GP_GC = 51456, GP_BETA = 51712, GP_EG = 51968, GP_DG = 52224, GP_RQ = 52480, GP_RK = 52736, GP_SQP = 52992, GP_RHS = 53760, GP_QGT = 119296;
__device__ __forceinline__ void gdn_prep_item(FA, int l, int it, unsigned* prev_ready) {
    const int tid = F.tid, lane = F.lane, wave = F.wave;
    const bool samp = it >= 1024;
    const int h = it & 3, sb = samp ? ((it - 1024) >> 2) : (it >> 9), c = samp ? 0 : ((it >> 2) & 127);
    const int ntok = samp ? 16 : 64;
    const int row0 = samp ? (MP + sb * 16) : (sb * SEQ + c * 64);
    const bf16* PROJ = (const bf16*)(F.ws + WS_BIG);
    LAS bf16* QL = (LAS bf16*)(F.lds + GP_QL); LAS bf16* KL = (LAS bf16*)(F.lds + GP_KL); LAS float* LM = (LAS float*)(F.lds + GP_LM);
    LAS float* GC = (LAS float*)(F.lds + GP_GC); LAS float* BETA = (LAS float*)(F.lds + GP_BETA); LAS float* EG = (LAS float*)(F.lds + GP_EG); LAS float* DG = (LAS float*)(F.lds + GP_DG);
    LAS float* RQ = (LAS float*)(F.lds + GP_RQ); LAS float* RK = (LAS float*)(F.lds + GP_RK); LAS float* SQP = (LAS float*)(F.lds + GP_SQP); LAS float* RHS = (LAS float*)(F.lds + GP_RHS); LAS bf16* QGT = (LAS bf16*)(F.lds + GP_QGT);
    bf16* WKN = (bf16*)(F.ws + WS_WKN) + (size_t)it * 8192; bf16* QG = (bf16*)(F.ws + WS_QG) + (size_t)it * 8192; bf16* KDT = (bf16*)(F.ws + WS_KDT) + (size_t)it * 8192;
    bf16* U0L = (bf16*)(F.ws + WS_U0L) + (size_t)it * 8192; bf16* QKM = (bf16*)(F.ws + WS_QKM) + (size_t)it * 4096; float* GL = (float*)(F.ws + WS_GL);
    const int kind = tid >> 7, ch = tid & 127;
    LAS bf16* XT = (LAS bf16*)(F.lds + GP_XT);
    v4u xr[7];
#pragma unroll
    for (int k = 0; k < 7; ++k) { const int idx = tid + 512 * k, r = idx / 48, sg = idx - r * 48; xr[k] = (v4u){0u, 0u, 0u, 0u};
        if (idx < 67 * 48 && r < 3 + ntok && (r >= 3 || (!samp && c > 0))) xr[k] = *(const v4u*)(PROJ + (size_t)(row0 - 3 + r) * NPROJ + (sg >> 4) * 512 + h * 128 + (sg & 15) * 8); }
    float w0 = 0.f, w1 = 0.f, w2 = 0.f, w3 = 0.f;
    if (kind < 3) { const float* wc = INP(I_WGCONV) + (size_t)l * 4 * 1536 + kind * 512 + h * 128 + ch; w0 = wc[0]; w1 = wc[1536]; w2 = wc[2 * 1536]; w3 = wc[3 * 1536]; }
    if (wave == 6) {
        const int i = lane; float g = 0.f, be = 0.f;
        if (i < ntok) { const float* ab = (const float*)(F.ws + WS_AB) + (size_t)(row0 + i) * 8;
            const float x = ab[h] + INP(I_DTB)[l * 4 + h]; const float ex = __expf(x); const float sp = (x > 20.f) ? x : ((x < -8.f) ? ex : __logf(1.0f + ex));
            g = -__expf(INP(I_ALOG)[l * 4 + h]) * sp; be = 1.0f / (1.0f + __expf(-ab[4 + h])); }
        float gc = g;
#pragma unroll
        for (int o = 1; o < 64; o <<= 1) { EG[i] = gc; LDS_WAIT(); asm volatile("" ::: "memory"); const float t = EG[(i - o) & 63]; LDS_WAIT(); asm volatile("" ::: "memory"); if (i >= o) gc += t; }
        EG[i] = gc; LDS_WAIT(); asm volatile("" ::: "memory");
        const float gtot = EG[63]; LDS_WAIT(); asm volatile("" ::: "memory");
        GC[i] = gc; BETA[i] = be; EG[i] = __expf(gc); DG[i] = __expf(gtot - gc);
        if (lane == 63) __hip_atomic_store(GL + it, __expf(gtot), __ATOMIC_RELAXED, __HIP_MEMORY_SCOPE_AGENT);
    }
#pragma unroll
    for (int k = 0; k < 7; ++k) { const int idx = tid + 512 * k; if (idx < 67 * 48) *(LAS v4u*)(F.lds + GP_XT + idx * 16) = xr[k]; }
    asm volatile("s_waitcnt vmcnt(0)" ::: "memory");
    __syncthreads();
    if (prev_ready && tid == 0) __hip_atomic_store(prev_ready, 1u, __ATOMIC_RELAXED, __HIP_MEMORY_SCOPE_AGENT);
    float val[64];
    if (kind < 3) {
        const int gch = kind * 512 + h * 128 + ch;
        const LAS bf16* xt = XT + kind * 128 + ch;
        float xm3 = bf2f(xt[0]), xm2 = bf2f(xt[384]), xm1 = bf2f(xt[768]);
        if (samp) { const float* st = INP(I_SGCONV) + ((size_t)(l * 16 + sb) * 3) * 1536 + gch; xm3 = st[0]; xm2 = st[1536]; xm1 = st[2 * 1536]; }
#pragma unroll
        for (int i = 0; i < 64; ++i) {
            float x = 0.f, v = 0.f;
            if (i < ntok) { x = bf2f(xt[(i + 3) * 384]); const float y = (w0 * xm3 + w1 * xm2) + (w2 * xm1 + w3 * x); v = silu_f(y); }
            val[i] = v; xm3 = xm2; xm2 = xm1; xm1 = x;
            if (i == 15 && samp) { float* o = F.out + O_SGC + ((size_t)(l * 16 + sb) * 3) * 1536 + gch; o[0] = xm3; o[1536] = xm2; o[2 * 1536] = xm1; }
            if (i == 63 && !samp && c == 127) { float* o = F.out + O_PGC + ((size_t)(l * 2 + sb) * 3) * 1536 + gch; o[0] = xm3; o[1536] = xm2; o[2 * 1536] = xm1; }
        }
        if (kind < 2) {
            LAS float* T = (LAS float*)(F.lds + GP_RHS) + (size_t)(kind * 64) * 132 + ch;
#pragma unroll
            for (int i = 0; i < 64; ++i) T[i * 132] = val[i] * val[i];
        }
    } else {
#pragma unroll
        for (int i = 0; i < 64; ++i) val[i] = 0.f;
    }
    __syncthreads();
    { const int p = tid >> 2, qd = tid & 3;
      const LAS float* T = (const LAS float*)(F.lds + GP_RHS) + (size_t)p * 132 + 32 * qd;
      float s = 0.f;
#pragma unroll
      for (int j = 0; j < 8; ++j) { const f32x4 v = *(const LAS f32x4*)(T + 4 * j); s += (v[0] + v[1]) + (v[2] + v[3]); }
      s = xadd<1>(s); s = xadd<2>(s);
      if (qd == 0) { if (p < 64) RQ[p] = (1.0f / sqrtf(s + EPS)) * 0.08838834764831845f; else RK[p - 64] = 1.0f / sqrtf(s + EPS); } }
    __syncthreads();
    if (kind == 0) {
#pragma unroll
        for (int i = 0; i < 64; ++i) { const float qn = val[i] * RQ[i]; QL[i * 136 + ch] = f2bf(qn); QGT[i * 128 + ch] = f2bf(qn * EG[i]); }
    } else if (kind == 1) {
        bf16* kdp = launder_g(KDT + (size_t)ch * 64);
#pragma unroll
        for (int i8 = 0; i8 < 8; ++i8) { float kd[8];
#pragma unroll
            for (int j = 0; j < 8; ++j) { const int i = i8 * 8 + j; const float kn = val[i] * RK[i]; KL[i * 136 + ch] = f2bf(kn); kd[j] = kn * DG[i]; RHS[i * 256 + ch] = BETA[i] * EG[i] * kn; }
            { const int s_ = i8 >> 2, a_ = (i8 >> 1) & 1, g_ = 2 * (i8 & 1);
              v2u o0, o1; o0.x = pk2(kd[0], kd[1]); o0.y = pk2(kd[2], kd[3]); o1.x = pk2(kd[4], kd[5]); o1.y = pk2(kd[6], kd[7]);
              __hip_atomic_store((u64*)(kdp + 32 * s_ + 8 * g_ + 4 * a_), (u64)o0.x | ((u64)o0.y << 32), __ATOMIC_RELAXED, __HIP_MEMORY_SCOPE_AGENT);
              __hip_atomic_store((u64*)(kdp + 32 * s_ + 8 * (g_ + 1) + 4 * a_), (u64)o1.x | ((u64)o1.y << 32), __ATOMIC_RELAXED, __HIP_MEMORY_SCOPE_AGENT); } }
    } else if (kind == 2) {
#pragma unroll
        for (int i = 0; i < 64; ++i) RHS[i * 256 + 128 + ch] = BETA[i] * val[i];
    }
    __syncthreads();
    {
        const int rt = wave & 3, g = lane >> 4, n = lane & 15;
        LAS bf16* As = (wave < 4) ? KL : QL;
        f32x4 acc[4];
#pragma unroll
        for (int t = 0; t < 4; ++t) acc[t] = (f32x4){0.f, 0.f, 0.f, 0.f};
#pragma unroll
        for (int s = 0; s < 4; ++s) { const bf16x8 a = *(const LAS bf16x8*)(As + (16 * rt + n) * 136 + 32 * s + 8 * g);
#pragma unroll
            for (int t = 0; t < 4; ++t) { const bf16x8 b = *(const LAS bf16x8*)(KL + (16 * t + n) * 136 + 32 * s + 8 * g); acc[t] = mfma16(a, b, acc[t]); } }
#pragma unroll
        for (int t = 0; t < 4; ++t) { const int j = 16 * t + n; const float gj = GC[j];
#pragma unroll
            for (int r = 0; r < 4; ++r) { const int i = 16 * rt + 4 * g + r; const float d = __expf(fminf(GC[i] - gj, 0.f));
                if (wave < 4) LM[i * 64 + j] = (i > j) ? BETA[i] * acc[t][r] * d : 0.f;
                else acc[t][r] = (i >= j) ? acc[t][r] * d : 0.f; } }
        __syncthreads();
        if (wave >= 4) {
#pragma unroll
            for (int t = 0; t < 4; ++t)
#pragma unroll
                for (int r = 0; r < 4; ++r) QL[(16 * rt + 4 * g + r) * 64 + 16 * t + n] = f2bf(acc[t][r]); }
    }
    const bool solver = (kind == 1 || kind == 2);
    float x[64];
    if (solver) {
#pragma unroll
        for (int i = 0; i < 32; ++i) x[i] = RHS[i * 256 + (tid - 128)];
#pragma unroll
        for (int i = 0; i < 32; ++i) {
            float p[4] = {0.f, 0.f, 0.f, 0.f};
#pragma unroll
            for (int j4 = 0; j4 < (i + 3) / 4; ++j4) { const f32x4 lv = *(const LAS f32x4*)(LM + i * 64 + 4 * j4);
#pragma unroll
                for (int jj = 0; jj < 4; ++jj) if (4 * j4 + jj < i) p[jj] += lv[jj] * x[4 * j4 + jj]; }
            x[i] = x[i] - ((p[0] + p[1]) + (p[2] + p[3]));
            RHS[i * 256 + (tid - 128)] = x[i];
            if (i & 1) asm volatile("" ::: "memory");
        }
    }
    __syncthreads();
    { const int g = lane >> 4, n = lane & 15;
#pragma unroll
      for (int q = 0; q < 4; ++q) { const int nt = 2 * wave + (q & 1), mt = q >> 1;
          LAS float* cp = RHS + (32 + 16 * mt + 4 * g) * 256 + 16 * nt + n;
          f32x4 c = (f32x4){cp[0], cp[256], cp[512], cp[768]};
#pragma unroll
          for (int ks = 0; ks < 8; ++ks) c = __builtin_amdgcn_mfma_f32_16x16x4f32(-LM[(32 + 16 * mt + n) * 64 + 4 * ks + g], RHS[(4 * ks + g) * 256 + 16 * nt + n], c, 0, 0, 0);
          cp[0] = c[0]; cp[256] = c[1]; cp[512] = c[2]; cp[768] = c[3]; } }
    __syncthreads();
    if (solver) {
#pragma unroll
        for (int i = 32; i < 64; ++i) x[i] = RHS[i * 256 + (tid - 128)];
#pragma unroll
        for (int i = 32; i < 64; ++i) {
            float p[4] = {0.f, 0.f, 0.f, 0.f};
#pragma unroll
            for (int j4 = 8; j4 < (i + 3) / 4; ++j4) { const f32x4 lv = *(const LAS f32x4*)(LM + i * 64 + 4 * j4);
#pragma unroll
                for (int jj = 0; jj < 4; ++jj) if (4 * j4 + jj < i) p[jj] += lv[jj] * x[4 * j4 + jj]; }
            x[i] = x[i] - ((p[0] + p[1]) + (p[2] + p[3]));
            if (i & 1) asm volatile("" ::: "memory");
        }
        if (kind == 1) {
            const int pos = (ch & ~31) | (((ch >> 2) & 3) << 3) | (((ch >> 4) & 1) << 2) | (ch & 3);
#pragma unroll
            for (int i = 0; i < 64; ++i) KL[i * 128 + pos] = f2bf(-x[i]);
        } else {
            const int ws_ = ch >> 4, n = ch & 15; bf16* u0p = launder_g(U0L + ((size_t)(ws_ * 4) * 64 + n) * 4);
#pragma unroll
            for (int t = 0; t < 4; ++t)
#pragma unroll
                for (int g = 0; g < 4; ++g) __hip_atomic_store((u64*)(u0p + (t * 64 + 16 * g) * 4), (u64)pk2(x[16 * t + 4 * g], x[16 * t + 4 * g + 1]) | ((u64)pk2(x[16 * t + 4 * g + 2], x[16 * t + 4 * g + 3]) << 32), __ATOMIC_RELAXED, __HIP_MEMORY_SCOPE_AGENT);
        }
    }
    __syncthreads();
    { const LAS unsigned char* qgt = F.lds + GP_QGT; const LAS unsigned char* wkt = F.lds + GP_KL; const LAS unsigned char* qkt = F.lds + GP_QL;
#pragma unroll
      for (int k = 0; k < 2; ++k) { const int o = (tid + 512 * k) * 16;
          st_wt16((unsigned char*)QG + o, *(const LAS bf16x8*)(qgt + o)); st_wt16((unsigned char*)WKN + o, *(const LAS bf16x8*)(wkt + o)); }
      st_wt16((unsigned char*)QKM + tid * 16, *(const LAS bf16x8*)(qkt + tid * 16)); }
    __syncthreads();
}

constexpr int SC_WK = 0, SC_KD = 17408, SC_BUF = 35840;
constexpr int CW_QH = 60032, CW_SDONE = 61056;
constexpr int CW_READY = 32768, CW_PROG = CW_READY + 8 * 1024;
constexpr size_t WS_SB = WS_QATT, WS_UB = WS_QATT + 34 * MiB;
static_assert((size_t)NITEM * 32768 <= 34 * MiB && WS_UB + (size_t)NITEM * 16384 <= WS_GREG + 90 * MiB, "SB/UB fit");
struct ScanStage { v4u R[4]; v2u U0n[4]; float gln; };
__device__ __forceinline__ void sc_load(FA, ScanStage& st, int it, int tid, int w, int lane) {
    const int r4 = tid >> 4, c4 = tid & 15, r3 = tid >> 3, c3 = tid & 7;
    const bf16* wk_ = (const bf16*)(F.ws + WS_WKN) + (size_t)it * 8192; const bf16* kd_ = (const bf16*)(F.ws + WS_KDT) + (size_t)it * 8192; const bf16* u0_ = (const bf16*)(F.ws + WS_U0L) + (size_t)it * 8192;
    st.R[0] = *(const v4u*)(wk_ + r4 * 128 + c4 * 8); st.R[1] = *(const v4u*)(wk_ + (r4 + 32) * 128 + c4 * 8);
    st.R[2] = *(const v4u*)(kd_ + r3 * 64 + c3 * 8); st.R[3] = *(const v4u*)(kd_ + (r3 + 64) * 64 + c3 * 8);
#pragma unroll
    for (int t = 0; t < 4; ++t) st.U0n[t] = *(const v2u*)(u0_ + ((size_t)(w * 4 + t) * 64 + lane) * 4);
    { int z_ = 0; asm volatile("" : "+v"(z_));
      st.gln = ((const float*)(F.ws + WS_GL))[it + z_]; }
}
__device__ __forceinline__ void sc_store(FA, const ScanStage& st, int buf, int tid) {
    const int r4 = tid >> 4, c4 = tid & 15, r3 = tid >> 3, c3 = tid & 7;
    LAS unsigned char* b_ = F.lds + buf * SC_BUF;
    *(LAS v4u*)(b_ + SC_WK + r4 * 272 + c4 * 16) = st.R[0]; *(LAS v4u*)(b_ + SC_WK + (r4 + 32) * 272 + c4 * 16) = st.R[1];
    *(LAS v4u*)(b_ + SC_KD + r3 * 144 + c3 * 16) = st.R[2]; *(LAS v4u*)(b_ + SC_KD + (r3 + 64) * 144 + c3 * 16) = st.R[3];
}
__device__ __forceinline__ void sc_chunk(FA, f32x4 (&S)[8], const v2u (&U0c)[4], float gl, int buf, int it, int w, int lane) {
    const int g = lane >> 4, n = lane & 15;
    const LAS unsigned char* b = F.lds + buf * SC_BUF;
    const unsigned fa = (unsigned)(n * 272 + g * 8), fk = (unsigned)(n * 144 + g * 8);
    unsigned char* sbp = F.ws + WS_SB + (((size_t)it * 8 + w) * 4 * 64 + lane) * 16;
    unsigned char* ubp = F.ws + WS_UB + (((size_t)it * 8 + w) * 2 * 64 + lane) * 16;
    bf16x8 Sb[4];
#pragma unroll
    for (int s = 0; s < 4; ++s) { Sb[s] = mk8(pk2(S[2 * s][0], S[2 * s][1]), pk2(S[2 * s][2], S[2 * s][3]), pk2(S[2 * s + 1][0], S[2 * s + 1][1]), pk2(S[2 * s + 1][2], S[2 * s + 1][3])); st_wt16(sbp + s * 1024, Sb[s]); }
    const unsigned fa2 = (unsigned)(n * 272 + g * 16), fk2 = (unsigned)(n * 144 + g * 16);
    bf16x8 fr[2][4];
    f32x4 U[4];
#pragma unroll
    for (int t = 0; t < 4; ++t) U[t] = (f32x4){bflo(U0c[t].x), bfhi(U0c[t].x), bflo(U0c[t].y), bfhi(U0c[t].y)};
#pragma unroll
    for (int hh = 0; hh < 2; ++hh) {
#pragma unroll
        for (int s = 0; s < 2; ++s)
#pragma unroll
            for (int t = 0; t < 4; ++t) fr[s][t] = *(const LAS bf16x8*)(b + SC_WK + fa2 + t * (16 * 272) + (2 * hh + s) * 64);
        __builtin_amdgcn_sched_barrier(0);
#pragma unroll
        for (int s = 0; s < 2; ++s)
#pragma unroll
            for (int t = 0; t < 4; ++t) U[t] = mfma16(fr[s][t], Sb[2 * hh + s], U[t]);
        __builtin_amdgcn_sched_barrier(0);
    }
#pragma unroll
    for (int t = 0; t < 8; ++t) S[t] = S[t] * gl;
    bf16x8 Ub[2];
#pragma unroll
    for (int s = 0; s < 2; ++s) {
#pragma unroll
        for (int t = 0; t < 8; ++t) fr[t >> 2][t & 3] = *(const LAS bf16x8*)(b + SC_KD + fk2 + t * (16 * 144) + s * 64);
        __builtin_amdgcn_sched_barrier(0);
        if (s == 0) {
#pragma unroll
            for (int q = 0; q < 2; ++q) { Ub[q] = mk8(pk2(U[2 * q][0], U[2 * q][1]), pk2(U[2 * q][2], U[2 * q][3]), pk2(U[2 * q + 1][0], U[2 * q + 1][1]), pk2(U[2 * q + 1][2], U[2 * q + 1][3])); st_wt16(ubp + q * 1024, Ub[q]); }
        }
#pragma unroll
        for (int t = 0; t < 8; ++t) S[t] = mfma16(fr[t >> 2][t & 3], Ub[s], S[t]);
        __builtin_amdgcn_sched_barrier(0);
    }
}
__device__ __forceinline__ void sc_wait_ready(const unsigned* flags, int cnt, int lane) {
    unsigned spins = 0;
    for (;;) {
        unsigned v = 1u; if (lane < cnt) v = __hip_atomic_load(flags + lane, __ATOMIC_RELAXED, __HIP_MEMORY_SCOPE_AGENT);
        if (__all(v != 0u)) break;
        __builtin_amdgcn_s_sleep(4);
        if (++spins > (1u << 20)) break;
    }
    __builtin_amdgcn_fence(__ATOMIC_ACQUIRE, "agent");
    asm volatile("s_waitcnt vmcnt(0)" ::: "memory");
}
__device__ __forceinline__ void gdn_scan_prompt(FA, int l, int sbk, int fl) {
    const int tid = F.tid, lane = F.lane, wv = F.wave, g = lane >> 4, n = lane & 15;
    const int seq = sbk >> 1, half = sbk & 1; const bool cw = wv < 4; const int w = half * 4 + (wv & 3);
    const int b = seq >> 2, h = seq & 3, it0 = b * 512 + h;
    const unsigned* ready = F.ctl + CW_READY + fl * 1024 + seq * 128;
    unsigned* prog = F.ctl + CW_PROG + ((fl * 8 + seq) * 2 + half) * 64;
    f32x4 S[8];
#pragma unroll
    for (int t = 0; t < 8; ++t) S[t] = (f32x4){0.f, 0.f, 0.f, 0.f};
    if (cw) __builtin_amdgcn_s_setprio(2);
    if (wv == 0) sc_wait_ready(ready, 9, lane);
    __syncthreads();
    ScanStage s0, s1, s2;
    v2u U0c[4]; float gl;
#define SC_ISSUE(K, ST) do { const int k_ = (K); if (k_ < 128) { \
        if ((k_ & 7) == 1 && k_ > 1) { if (wv == 4) sc_wait_ready(ready + k_, (128 - k_) < 8 ? (128 - k_) : 8, lane); __syncthreads(); }     \
        sc_load(F, A, ST, it0 + k_ * 4, tid, w, lane); } } while (0)
#define SC_STEP(C, ST) do { const int c_ = (C); if (c_ < 128) { \
        if (cw) sc_chunk(F, A, S, U0c, gl, c_ & 1, it0 + c_ * 4, w, lane); \
        if (c_ + 1 < 128) { sc_store(F, A, ST, (c_ + 1) & 1, tid); _Pragma("unroll") for (int t = 0; t < 4; ++t) U0c[t] = ST.U0n[t]; gl = ST.gln; SC_ISSUE(c_ + 4, ST); } \
        __syncthreads(); \
        if (tid == 0 && c_ >= 3 && c_ + 1 < 128) __hip_atomic_store(prog, (unsigned)(c_ - 2), __ATOMIC_RELAXED, __HIP_MEMORY_SCOPE_AGENT); } } while (0)
    sc_load(F, A, s0, it0, tid, w, lane); sc_store(F, A, s0, 0, tid);
#pragma unroll
    for (int t = 0; t < 4; ++t) U0c[t] = s0.U0n[t];
    gl = s0.gln;
    SC_ISSUE(1, s1); SC_ISSUE(2, s2); SC_ISSUE(3, s0);
    __syncthreads();
    for (int c = 0; c < 128; c += 3) { SC_STEP(c, s1); SC_STEP(c + 1, s2); SC_STEP(c + 2, s0); }
#undef SC_ISSUE
#undef SC_STEP
    __builtin_amdgcn_s_setprio(0);
    asm volatile("s_waitcnt vmcnt(0)" ::: "memory");
    __syncthreads();
    if (tid == 0) __hip_atomic_store(prog, 128u, __ATOMIC_RELAXED, __HIP_MEMORY_SCOPE_AGENT);
    float* Sout = F.out + O_PSG + ((size_t)(l * 2 + b) * 4 + h) * 16384;
    if (cw) {
#pragma unroll
    for (int t = 0; t < 8; ++t)
#pragma unroll
        for (int r = 0; r < 4; ++r) Sout[(size_t)(16 * t + 4 * g + r) * 128 + 16 * w + n] = S[t][r];
    }
}
constexpr int OI_QG = 0, OI_QK = 17408, OI_OT = 26624;
__device__ __forceinline__ void gdn_o_item(FA, int l, int it, int row0, int ntok, int h) {
    const int tid = F.tid, lane = F.lane, w = F.wave, g = lane >> 4, n = lane & 15;
    { const int r4 = tid >> 4, c4 = tid & 15, r3 = tid >> 3, c3 = tid & 7;
      const bf16* qg_ = (const bf16*)(F.ws + WS_QG) + (size_t)it * 8192; const bf16* qk_ = (const bf16*)(F.ws + WS_QKM) + (size_t)it * 4096;
      const v4u a0 = *(const v4u*)(qg_ + r4 * 128 + c4 * 8), a1 = *(const v4u*)(qg_ + (r4 + 32) * 128 + c4 * 8), a2 = *(const v4u*)(qk_ + r3 * 64 + c3 * 8);
      *(LAS v4u*)(F.lds + OI_QG + r4 * 272 + c4 * 16) = a0; *(LAS v4u*)(F.lds + OI_QG + (r4 + 32) * 272 + c4 * 16) = a1; *(LAS v4u*)(F.lds + OI_QK + r3 * 144 + c3 * 16) = a2; }
    const unsigned char* sbp = F.ws + WS_SB + (((size_t)it * 8 + w) * 4 * 64 + lane) * 16;
    const unsigned char* ubp = F.ws + WS_UB + (((size_t)it * 8 + w) * 2 * 64 + lane) * 16;
    bf16x8 Sb[4], Ub[2];
#pragma unroll
    for (int s = 0; s < 4; ++s) Sb[s] = *(const bf16x8*)(sbp + s * 1024);
#pragma unroll
    for (int s = 0; s < 2; ++s) Ub[s] = *(const bf16x8*)(ubp + s * 1024);
    __syncthreads();
    const unsigned fa = (unsigned)(n * 272 + g * 8), fk = (unsigned)(n * 144 + g * 8);
    f32x4 O[4];
#pragma unroll
    for (int t = 0; t < 4; ++t) O[t] = (f32x4){0.f, 0.f, 0.f, 0.f};
#pragma unroll
    for (int s = 0; s < 4; ++s)
#pragma unroll
        for (int t = 0; t < 4; ++t) { const LAS unsigned char* p = F.lds + OI_QG + fa + t * (16 * 272) + s * 64; const v2u a0 = *(const LAS v2u*)p, a1 = *(const LAS v2u*)(p + 32);
            O[t] = mfma16(mk8(a0.x, a0.y, a1.x, a1.y), Sb[s], O[t]); }
#pragma unroll
    for (int s = 0; s < 2; ++s)
#pragma unroll
        for (int t = 0; t < 4; ++t) { const LAS unsigned char* p = F.lds + OI_QK + fk + t * (16 * 144) + s * 64; const v2u a0 = *(const LAS v2u*)p, a1 = *(const LAS v2u*)(p + 32);
            O[t] = mfma16(mk8(a0.x, a0.y, a1.x, a1.y), Ub[s], O[t]); }
    LAS float* OT = (LAS float*)(F.lds + OI_OT);
#pragma unroll
    for (int t = 0; t < 4; ++t)
#pragma unroll
        for (int r = 0; r < 4; ++r) OT[(16 * t + 4 * g + r) * 132 + 16 * w + n] = O[t][r];
    __syncthreads();
    { const int r = tid >> 3, c0 = (tid & 7) * 16;
      float o[16]; float ss = 0.f;
#pragma unroll
      for (int j = 0; j < 4; ++j) { const f32x4 v = *(const LAS f32x4*)(OT + r * 132 + c0 + 4 * j); o[4 * j] = v[0]; o[4 * j + 1] = v[1]; o[4 * j + 2] = v[2]; o[4 * j + 3] = v[3]; ss += (v[0] * v[0] + v[1] * v[1]) + (v[2] * v[2] + v[3] * v[3]); }
      ss = xadd<1>(ss); ss = xadd<2>(ss); ss = xadd<4>(ss);
      if (r < ntok) {
          const float rn = __builtin_amdgcn_rsqf(ss * (1.0f / 128.0f) + EPS);
          const size_t row = (size_t)row0 + r;
          const bf16* zp = (const bf16*)(F.ws + WS_BIG) + row * NPROJ + PC_Z + h * 128 + c0;
          const v4u z0 = *(const v4u*)zp, z1 = *(const v4u*)(zp + 8);
          const float z[16] = {bflo(z0.x), bfhi(z0.x), bflo(z0.y), bfhi(z0.y), bflo(z0.z), bfhi(z0.z), bflo(z0.w), bfhi(z0.w), bflo(z1.x), bfhi(z1.x), bflo(z1.y), bfhi(z1.y), bflo(z1.z), bfhi(z1.z), bflo(z1.w), bfhi(z1.w)};
          const float* gn = INP(I_GNG) + l * 128 + c0;
#pragma unroll
          for (int j = 0; j < 16; ++j) o[j] = o[j] * rn * gn[j] * silu_f(z[j]);
          v4u w0, w1; w0.x = pk2(o[0], o[1]); w0.y = pk2(o[2], o[3]); w0.z = pk2(o[4], o[5]); w0.w = pk2(o[6], o[7]); w1.x = pk2(o[8], o[9]); w1.y = pk2(o[10], o[11]); w1.z = pk2(o[12], o[13]); w1.w = pk2(o[14], o[15]);
          bf16* mp = (bf16*)(F.ws + WS_MIX) + row * 1024 + h * 128 + c0;
          *(v4u*)mp = w0; *(v4u*)(mp + 8) = w1; } }
    __syncthreads();
}
__device__ __forceinline__ void gdn_sample_scan(FA, int l, int it) {
    const int tid = F.tid, lane = F.lane, w = F.wave, g = lane >> 4, n = lane & 15;
    const int k = it - 1024, s_ = k >> 2, h = k & 3;
    __builtin_amdgcn_fence(__ATOMIC_ACQUIRE, "agent"); asm volatile("s_waitcnt vmcnt(0)" ::: "memory"); __syncthreads();
    const float* S0 = INP(I_SGDN) + ((size_t)(l * 16 + s_) * 4 + h) * 16384;
    f32x4 S[8];
#pragma unroll
    for (int t = 0; t < 8; ++t)
#pragma unroll
        for (int r = 0; r < 4; ++r) S[t][r] = S0[(size_t)(16 * t + 4 * g + r) * 128 + 16 * w + n];
    ScanStage st; sc_load(F, A, st, it, tid, w, lane); sc_store(F, A, st, 0, tid);
    __syncthreads();
    sc_chunk(F, A, S, st.U0n, st.gln, 0, it, w, lane);
    float* Sout = F.out + O_SSG + ((size_t)(l * 16 + s_) * 4 + h) * 16384;
#pragma unroll
    for (int t = 0; t < 8; ++t)
#pragma unroll
        for (int r = 0; r < 4; ++r) Sout[(size_t)(16 * t + 4 * g + r) * 128 + 16 * w + n] = S[t][r];
    asm volatile("s_waitcnt vmcnt(0)" ::: "memory"); __syncthreads();
}
__device__ __forceinline__ int gdn_item_of(int j) { return j < 1024 ? ((((j >> 2) & 1) * 128 + (j >> 3)) * 4 + (j & 3)) : j; }
constexpr int SW_KL = 0, SW_VT = 27648;
__device__ __forceinline__ void swa_item(FA, int l, int item) {
    const int tid = F.tid, lane = F.lane, w = F.wave, g = lane >> 4, n = lane & 15;
    const bool samp = item >= 512;
    const int hk = item & 1, sb = samp ? ((item - 512) >> 1) : (item >> 8), c = samp ? 0 : ((item >> 1) & 127);
    const int c0 = (c >= 2) ? c - 2 : 0;
    const int nkeys = samp ? 144 : (c - c0 + 1) * 64, nkp = (nkeys + 31) & ~31;
    const int krow0 = samp ? (MP + sb * 16 - 128) : (sb * SEQ + c0 * 64);
    const bf16* PROJ = (const bf16*)(F.ws + WS_BIG);
    LAS bf16* KL = (LAS bf16*)(F.lds + SW_KL); LAS bf16* VT = (LAS bf16*)(F.lds + SW_VT);
    const float* gk = INP(I_SKG) + l * 64;
    for (int idx = tid; idx < nkp * 8; idx += NWAVES * 64) {
        const int key = idx >> 3, ch = idx & 7;
        float kv[8], vv[8];
        if (key >= nkeys) {
#pragma unroll
            for (int j = 0; j < 8; ++j) { kv[j] = 0.f; vv[j] = 0.f; }
        } else if (samp && key < 128) {
            const float* kp = INP(I_CSK) + ((size_t)(l * 16 + sb) * 128 + key) * 128 + hk * 64 + ch * 8; const float* vp = INP(I_CSV) + ((size_t)(l * 16 + sb) * 128 + key) * 128 + hk * 64 + ch * 8;
            const f32x4 k0 = *(const f32x4*)kp, k1 = *(const f32x4*)(kp + 4), v0 = *(const f32x4*)vp, v1 = *(const f32x4*)(vp + 4);
#pragma unroll
            for (int j = 0; j < 4; ++j) { kv[j] = k0[j]; kv[4 + j] = k1[j]; vv[j] = v0[j]; vv[4 + j] = v1[j]; }
        } else {
            const size_t row = (size_t)(krow0 + key);
            const v4u kb = *(const v4u*)(PROJ + row * NPROJ + PC_SK + hk * 64 + ch * 8), vb = *(const v4u*)(PROJ + row * NPROJ + PC_SV + hk * 64 + ch * 8);
            kv[0] = bflo(kb.x); kv[1] = bfhi(kb.x); kv[2] = bflo(kb.y); kv[3] = bfhi(kb.y); kv[4] = bflo(kb.z); kv[5] = bfhi(kb.z); kv[6] = bflo(kb.w); kv[7] = bfhi(kb.w);
            vv[0] = bflo(vb.x); vv[1] = bfhi(vb.x); vv[2] = bflo(vb.y); vv[3] = bfhi(vb.y); vv[4] = bflo(vb.z); vv[5] = bfhi(vb.z); vv[6] = bflo(vb.w); vv[7] = bfhi(vb.w);
            float s = 0.f;
#pragma unroll
            for (int j = 0; j < 8; ++j) s += kv[j] * kv[j];
            s = xadd<1>(s); s = xadd<2>(s); s = xadd<4>(s);
            const float r = __builtin_amdgcn_rsqf(s * (1.0f / 64.0f) + EPS);
#pragma unroll
            for (int j = 0; j < 8; ++j) kv[j] = kv[j] * r * gk[ch * 8 + j];
            float* ok = nullptr; float* ov = nullptr;
            if (samp) { const size_t o = ((size_t)(l * 16 + sb) * 16 + (key - 128)) * 128 + hk * 64 + ch * 8; ok = F.out + O_SSK + o; ov = F.out + O_SSV + o; }
            else if (c >= 126 && key >= (c - c0) * 64) { const int t = c * 64 + (key - (c - c0) * 64) - (SEQ - 128);
                const size_t o = ((size_t)(l * 2 + sb) * 128 + t) * 128 + hk * 64 + ch * 8; ok = F.out + O_PSK + o; ov = F.out + O_PSV + o; }
            if (ok) { *(f32x4*)ok = (f32x4){kv[0], kv[1], kv[2], kv[3]}; *(f32x4*)(ok + 4) = (f32x4){kv[4], kv[5], kv[6], kv[7]};
                      *(f32x4*)ov = (f32x4){vv[0], vv[1], vv[2], vv[3]}; *(f32x4*)(ov + 4) = (f32x4){vv[4], vv[5], vv[6], vv[7]}; }
        }
        v4u kw; kw.x = pk2(kv[0], kv[1]); kw.y = pk2(kv[2], kv[3]); kw.z = pk2(kv[4], kv[5]); kw.w = pk2(kv[6], kv[7]);
        *(LAS v4u*)(KL + key * 72 + ch * 8) = kw;
#pragma unroll
        for (int j = 0; j < 8; ++j) VT[(ch * 8 + j) * 200 + key] = f2bf(vv[j]);
    }
    __syncthreads();
    const bool active = samp ? (w < 2) : true;
    if (active) {
        const int head = hk * 2 + (samp ? w : (w >> 2)), tok0 = samp ? 0 : 16 * (w & 3);
        const size_t qrow = (size_t)(samp ? (MP + sb * 16) : (sb * SEQ + c * 64)) + tok0 + n;
        const float* gq = INP(I_SQG) + l * 64;
        float q[16];
#pragma unroll
        for (int s = 0; s < 2; ++s) { const v4u qb = *(const v4u*)(PROJ + qrow * NPROJ + PC_SQ + head * 64 + 32 * s + 8 * g);
            q[8 * s + 0] = bflo(qb.x); q[8 * s + 1] = bfhi(qb.x); q[8 * s + 2] = bflo(qb.y); q[8 * s + 3] = bfhi(qb.y); q[8 * s + 4] = bflo(qb.z); q[8 * s + 5] = bfhi(qb.z); q[8 * s + 6] = bflo(qb.w); q[8 * s + 7] = bfhi(qb.w); }
        float ss = 0.f;
#pragma unroll
        for (int j = 0; j < 16; ++j) ss += q[j] * q[j];
        ss = xadd<16>(ss); ss = xadd32(ss);
        const float sc = (1.0f / sqrtf(ss * (1.0f / 64.0f) + EPS)) * 0.125f;
        bf16x8 qf[2];
#pragma unroll
        for (int s = 0; s < 2; ++s) { float t[8];
#pragma unroll
            for (int j = 0; j < 8; ++j) t[j] = q[8 * s + j] * sc * gq[32 * s + 8 * g + j];
            qf[s] = mk8(pk2(t[0], t[1]), pk2(t[2], t[3]), pk2(t[4], t[5]), pk2(t[6], t[7])); }
        const float sink = INP(I_SINK)[l * 4 + head];
        f32x4 st[12]; float mx = sink;
#pragma unroll
        for (int t = 0; t < 12; ++t) {
            if (16 * t < nkp) { f32x4 a = (f32x4){0.f, 0.f, 0.f, 0.f};
#pragma unroll
                for (int s = 0; s < 2; ++s) a = mfma16(*(const LAS bf16x8*)(KL + (16 * t + n) * 72 + 32 * s + 8 * g), qf[s], a);
#pragma unroll
                for (int r = 0; r < 4; ++r) if (16 * t + 4 * g + r >= nkeys) a[r] = -1e30f;
                st[t] = a; }
            else st[t] = (f32x4){-1e30f, -1e30f, -1e30f, -1e30f};
#pragma unroll
            for (int r = 0; r < 4; ++r) mx = fmaxf(mx, st[t][r]);
        }
        mx = xmax<16>(mx); mx = xmax32(mx);
        float sum = 0.f;
#pragma unroll
        for (int t = 0; t < 12; ++t)
#pragma unroll
            for (int r = 0; r < 4; ++r) { const float p = __expf(st[t][r] - mx); st[t][r] = p; sum += p; }
        sum = xadd<16>(sum); sum = xadd32(sum);
        const float inv = 1.0f / (sum + __expf(sink - mx));
        bf16x8 Pb[6];
#pragma unroll
        for (int k = 0; k < 6; ++k) Pb[k] = mk8(pk2(st[2 * k][0], st[2 * k][1]), pk2(st[2 * k][2], st[2 * k][3]), pk2(st[2 * k + 1][0], st[2 * k + 1][1]), pk2(st[2 * k + 1][2], st[2 * k + 1][3]));
        bf16* MIX = (bf16*)(F.ws + WS_MIX);
#pragma unroll
        for (int th = 0; th < 4; ++th) { f32x4 a = (f32x4){0.f, 0.f, 0.f, 0.f};
#pragma unroll
            for (int k = 0; k < 6; ++k) if (32 * k < nkp) { const LAS bf16* p = VT + (16 * th + n) * 200 + 32 * k + 4 * g; const v2u a0 = *(const LAS v2u*)p, a1 = *(const LAS v2u*)(p + 16);
                a = mfma16(mk8(a0.x, a0.y, a1.x, a1.y), Pb[k], a); }
            v2u o; o.x = pk2(a[0] * inv, a[1] * inv); o.y = pk2(a[2] * inv, a[3] * inv);
            *(v2u*)(MIX + qrow * 1024 + 512 + head * 64 + 16 * th + 4 * g) = o; }
    }
    __syncthreads();
}
__device__ __forceinline__ void sc_row(FA, int l, int row) {
    const int lane = F.lane, c = 4 * lane;
    const bool samp = row >= MP; const int t = samp ? ((row - MP) & 15) : (row & (SEQ - 1)), sb = samp ? ((row - MP) >> 4) : (row >> 13);
    const bf16* PROJ = (const bf16*)(F.ws + WS_BIG);
    float p[3][4];
#pragma unroll
    for (int d = 0; d < 3; ++d) { const int tt = t - 2 + d;
        if (tt >= 0) { const bf16* pr = PROJ + (size_t)(row - 2 + d) * NPROJ; const v2u a = *(const v2u*)(pr + PC_SCC + c), b = *(const v2u*)(pr + PC_SCH + c);
            p[d][0] = bflo(a.x) * bflo(b.x); p[d][1] = bfhi(a.x) * bfhi(b.x); p[d][2] = bflo(a.y) * bflo(b.y); p[d][3] = bfhi(a.y) * bfhi(b.y); }
        else if (samp) { const f32x4 v = *(const f32x4*)(INP(I_SSC) + ((size_t)(l * 16 + sb) * 2 + (tt + 2)) * 256 + c); p[d][0] = v[0]; p[d][1] = v[1]; p[d][2] = v[2]; p[d][3] = v[3]; }
        else { p[d][0] = 0.f; p[d][1] = 0.f; p[d][2] = 0.f; p[d][3] = 0.f; } }
    const float* wsc = INP(I_WSC) + (size_t)l * 3 * 256 + c;
    const f32x4 w0 = *(const f32x4*)wsc, w1 = *(const f32x4*)(wsc + 256), w2 = *(const f32x4*)(wsc + 512);
    const v2u bb = *(const v2u*)(PROJ + (size_t)row * NPROJ + PC_SCB + c);
    const float scb[4] = {bflo(bb.x), bfhi(bb.x), bflo(bb.y), bfhi(bb.y)};
    float o[4];
#pragma unroll
    for (int j = 0; j < 4; ++j) o[j] = scb[j] * ((w0[j] * p[0][j] + w1[j] * p[1][j]) + w2[j] * p[2][j]);
    v2u ow; ow.x = pk2(o[0], o[1]); ow.y = pk2(o[2], o[3]);
    *(v2u*)((bf16*)(F.ws + WS_MIX) + (size_t)row * 1024 + 768 + c) = ow;
    const int tl = samp ? 14 : SEQ - 2;
    if (t >= tl) { float* dst = samp ? F.out + O_SSC + ((size_t)(l * 16 + sb) * 2 + (t - tl)) * 256 + c : F.out + O_PSC + ((size_t)(l * 2 + sb) * 2 + (t - tl)) * 256 + c;
        *(f32x4*)dst = (f32x4){p[2][0], p[2][1], p[2][2], p[2][3]}; }
}
__device__ __forceinline__ void xattn_k_issue(FA, int l, int pm, int h, v4u (&kr)[16]) {
    const int tid = F.tid, b = pm >> 5;
    const bf16* K = (const bf16*)(F.ws + WS_MEMK) + ((size_t)l * 512 + b * 256) * 1024 + h * 256;
#pragma unroll
    for (int i = 0; i < 16; ++i) { const int idx = tid + 512 * i, key = idx >> 5, ch = idx & 31; kr[i] = *(const v4u*)(K + (size_t)key * 1024 + ch * 8); }
}
__device__ __forceinline__ void xattn_prompt_item(FA, int l, int pm, int h, const v4u (&kr)[16]) {
    const int tid = F.tid, lane = F.lane, w = F.wave, g = lane >> 4, n = lane & 15;
    const int b = pm >> 5;
    const bf16* K = (const bf16*)(F.ws + WS_MEMK) + ((size_t)l * 512 + b * 256) * 1024 + h * 256;
    const bf16* VT = (const bf16*)(F.ws + WS_MEMVT) + (size_t)((l * 2 + b) * 4 + h) * 65536;
    const bf16* QA = (const bf16*)(F.ws + WS_QATT);
    {
#pragma unroll
      for (int i = 0; i < 16; ++i) { const int idx = tid + 512 * i, key = idx >> 5, ch = idx & 31; *(LAS v4u*)(F.lds + key * 528 + ch * 16) = kr[i]; } }
    const size_t row0 = (size_t)pm * 256 + w * 32 + n;
    const float* gq = INP(I_MQG) + l * 256;
    bf16x8 q0[8], q1[8];
    { const f32x4 a0 = *(const f32x4*)((const float*)(F.ws + WS_QSS) + row0 * 16 + h * 4), a1 = *(const f32x4*)((const float*)(F.ws + WS_QSS) + (row0 + 16) * 16 + h * 4);
      const float r0 = (1.0f / sqrtf(((a0[0] + a0[1]) + (a0[2] + a0[3])) * (1.0f / 256.0f) + EPS)) * 0.0625f, r1 = (1.0f / sqrtf(((a1[0] + a1[1]) + (a1[2] + a1[3])) * (1.0f / 256.0f) + EPS)) * 0.0625f;
#pragma unroll
      for (int s = 0; s < 8; ++s) { const float* gg = gq + 32 * s + 8 * g;
          const v4u x = *(const v4u*)(QA + row0 * 1024 + h * 256 + 32 * s + 8 * g), y = *(const v4u*)(QA + (row0 + 16) * 1024 + h * 256 + 32 * s + 8 * g);
          q0[s] = mk8(pk2(bflo(x.x) * r0 * gg[0], bfhi(x.x) * r0 * gg[1]), pk2(bflo(x.y) * r0 * gg[2], bfhi(x.y) * r0 * gg[3]), pk2(bflo(x.z) * r0 * gg[4], bfhi(x.z) * r0 * gg[5]), pk2(bflo(x.w) * r0 * gg[6], bfhi(x.w) * r0 * gg[7]));
          q1[s] = mk8(pk2(bflo(y.x) * r1 * gg[0], bfhi(y.x) * r1 * gg[1]), pk2(bflo(y.y) * r1 * gg[2], bfhi(y.y) * r1 * gg[3]), pk2(bflo(y.z) * r1 * gg[4], bfhi(y.z) * r1 * gg[5]), pk2(bflo(y.w) * r1 * gg[6], bfhi(y.w) * r1 * gg[7])); } }
    __syncthreads();
    bf16x8 P0[8], P1[8]; float inv0, inv1;
    { f32x4 st0[16], st1[16];
      const LAS unsigned char* kb = F.lds + n * 528 + g * 16;
#pragma unroll
      for (int t = 0; t < 16; ++t) { f32x4 a0 = (f32x4){0.f, 0.f, 0.f, 0.f}, a1 = (f32x4){0.f, 0.f, 0.f, 0.f};
#pragma unroll
          for (int s = 0; s < 8; ++s) { const bf16x8 a = *(const LAS bf16x8*)(kb + t * (16 * 528) + s * 64); a0 = mfma16(a, q0[s], a0); a1 = mfma16(a, q1[s], a1); }
          st0[t] = a0; st1[t] = a1; }
      float m0 = -1e30f, m1 = -1e30f;
#pragma unroll
      for (int t = 0; t < 16; ++t)
#pragma unroll
          for (int r = 0; r < 4; ++r) { m0 = fmaxf(m0, st0[t][r]); m1 = fmaxf(m1, st1[t][r]); }
      m0 = xmax<16>(m0); m0 = xmax32(m0); m1 = xmax<16>(m1); m1 = xmax32(m1);
      float s0 = 0.f, s1 = 0.f;
#pragma unroll
      for (int t = 0; t < 16; ++t)
#pragma unroll
          for (int r = 0; r < 4; ++r) { const float p0 = __expf(st0[t][r] - m0), p1 = __expf(st1[t][r] - m1); st0[t][r] = p0; st1[t][r] = p1; s0 += p0; s1 += p1; }
      s0 = xadd<16>(s0); s0 = xadd32(s0); s1 = xadd<16>(s1); s1 = xadd32(s1);
      inv0 = 1.0f / s0; inv1 = 1.0f / s1;
#pragma unroll
      for (int k = 0; k < 8; ++k) { P0[k] = mk8(pk2(st0[2 * k][0], st0[2 * k][1]), pk2(st0[2 * k][2], st0[2 * k][3]), pk2(st0[2 * k + 1][0], st0[2 * k + 1][1]), pk2(st0[2 * k + 1][2], st0[2 * k + 1][3]));
                                    P1[k] = mk8(pk2(st1[2 * k][0], st1[2 * k][1]), pk2(st1[2 * k][2], st1[2 * k][3]), pk2(st1[2 * k + 1][0], st1[2 * k + 1][1]), pk2(st1[2 * k + 1][2], st1[2 * k + 1][3])); } }
    { v4u vr[16];
#pragma unroll
      for (int i = 0; i < 16; ++i) { const int idx = tid + 512 * i, hd = idx >> 5, ch = idx & 31; vr[i] = *(const v4u*)(VT + (size_t)hd * 256 + ch * 8); }
      __syncthreads();
#pragma unroll
      for (int i = 0; i < 16; ++i) { const int idx = tid + 512 * i, hd = idx >> 5, ch = idx & 31; *(LAS v4u*)(F.lds + hd * 528 + ch * 16) = vr[i]; } }
    __syncthreads();
    { const LAS unsigned char* vb = F.lds + n * 528 + g * 16;
      bf16* o0p = (bf16*)(F.ws + WS_ATT) + row0 * 1024 + h * 256 + 4 * g; bf16* o1p = o0p + 16 * 1024;
#pragma unroll 4
      for (int th = 0; th < 16; ++th) { f32x4 a0 = (f32x4){0.f, 0.f, 0.f, 0.f}, a1 = (f32x4){0.f, 0.f, 0.f, 0.f};
#pragma unroll
          for (int k = 0; k < 8; ++k) { const bf16x8 a = *(const LAS bf16x8*)(vb + th * (16 * 528) + k * 64); a0 = mfma16(a, P0[k], a0); a1 = mfma16(a, P1[k], a1); }
          v2u o; o.x = pk2(a0[0] * inv0, a0[1] * inv0); o.y = pk2(a0[2] * inv0, a0[3] * inv0); *(v2u*)(o0p + 16 * th) = o;
          o.x = pk2(a1[0] * inv1, a1[1] * inv1); o.y = pk2(a1[2] * inv1, a1[3] * inv1); *(v2u*)(o1p + 16 * th) = o; } }
    __syncthreads();
}
constexpr int XS_RED = 0, XS_SUM = 512, XS_PL = 1024;
__device__ __forceinline__ void xattn_sample_item(FA, int l, int item) {
    const int lane = F.lane, w = F.wave, g = lane >> 4, n = lane & 15;
    const int s_ = item >> 2, h = item & 3;
    const float* Kc = INP(I_CMK) + ((size_t)(l * 16 + s_) * 256) * 1024 + h * 256;
    const float* Vc = INP(I_CMV) + ((size_t)(l * 16 + s_) * 256) * 1024 + h * 256;
    LAS float* RED = (LAS float*)(F.lds + XS_RED); LAS float* SUM = (LAS float*)(F.lds + XS_SUM); LAS bf16* PL = (LAS bf16*)(F.lds + XS_PL);
    bf16* QA = (bf16*)(F.ws + WS_QATT);
    f32x4 kq[2][8][2];
#pragma unroll
    for (int t = 0; t < 2; ++t)
#pragma unroll
        for (int s = 0; s < 8; ++s) { const float* kp = Kc + (size_t)(32 * w + 16 * t + n) * 1024 + 32 * s + 8 * g; kq[t][s][0] = *(const f32x4*)kp; kq[t][s][1] = *(const f32x4*)(kp + 4); }
    __builtin_amdgcn_sched_barrier(0);
    const size_t row = (size_t)MP + s_ * 16 + n;
    const f32x4 qs = *(const f32x4*)((const float*)(F.ws + WS_QSS) + row * 16 + h * 4);
    const float rq = (1.0f / sqrtf(((qs[0] + qs[1]) + (qs[2] + qs[3])) * (1.0f / 256.0f) + EPS)) * 0.0625f;
    const float* gq = INP(I_MQG) + l * 256;
    bf16x8 qf[8];
#pragma unroll
    for (int s = 0; s < 8; ++s) { const v4u qb = *(const v4u*)(QA + row * 1024 + h * 256 + 32 * s + 8 * g); const float* gg = gq + 32 * s + 8 * g;
        qf[s] = mk8(pk2(bflo(qb.x) * rq * gg[0], bfhi(qb.x) * rq * gg[1]), pk2(bflo(qb.y) * rq * gg[2], bfhi(qb.y) * rq * gg[3]),
                    pk2(bflo(qb.z) * rq * gg[4], bfhi(qb.z) * rq * gg[5]), pk2(bflo(qb.w) * rq * gg[6], bfhi(qb.w) * rq * gg[7])); }
    f32x4 st[2]; float mx = -1e30f;
#pragma unroll
    for (int t = 0; t < 2; ++t) { f32x4 a = (f32x4){0.f, 0.f, 0.f, 0.f};
#pragma unroll
        for (int s = 0; s < 8; ++s) { const f32x4 k0 = kq[t][s][0], k1 = kq[t][s][1];
            a = mfma16(mk8(pk2(k0[0], k0[1]), pk2(k0[2], k0[3]), pk2(k1[0], k1[1]), pk2(k1[2], k1[3])), qf[s], a); }
        st[t] = a;
#pragma unroll
        for (int r = 0; r < 4; ++r) mx = fmaxf(mx, a[r]); }
    float vq[2][8][8];
#pragma unroll
    for (int th = 0; th < 2; ++th)
#pragma unroll
        for (int k = 0; k < 8; ++k) { const float* vp = Vc + (size_t)(32 * k + 8 * g) * 1024 + 32 * w + 16 * th + n;
#pragma unroll
            for (int j = 0; j < 8; ++j) vq[th][k][j] = vp[(size_t)j * 1024]; }
    mx = xmax<16>(mx); mx = xmax32(mx);
    if (g == 0) RED[w * 16 + n] = mx;
    __syncthreads();
    float gm = RED[n];
#pragma unroll
    for (int j = 1; j < 8; ++j) gm = fmaxf(gm, RED[j * 16 + n]);
    float sum = 0.f;
#pragma unroll
    for (int t = 0; t < 2; ++t) {
#pragma unroll
        for (int r = 0; r < 4; ++r) { const float p = __expf(st[t][r] - gm); st[t][r] = p; sum += p; }
        v2u pw; pw.x = pk2(st[t][0], st[t][1]); pw.y = pk2(st[t][2], st[t][3]);
        *(LAS v2u*)(PL + n * 264 + 32 * w + 16 * t + 4 * g) = pw; }
    sum = xadd<16>(sum); sum = xadd32(sum);
    if (g == 0) SUM[w * 16 + n] = sum;
    __syncthreads();
    float tot = 0.f;
#pragma unroll
    for (int j = 0; j < 8; ++j) tot += SUM[j * 16 + n];
    const float inv = 1.0f / tot;
#pragma unroll
    for (int th = 0; th < 2; ++th) { f32x4 a = (f32x4){0.f, 0.f, 0.f, 0.f};
#pragma unroll
        for (int k = 0; k < 8; ++k) { const bf16x8 av = mk8(pk2(vq[th][k][0], vq[th][k][1]), pk2(vq[th][k][2], vq[th][k][3]), pk2(vq[th][k][4], vq[th][k][5]), pk2(vq[th][k][6], vq[th][k][7]));
            a = mfma16(av, *(const LAS bf16x8*)(PL + n * 264 + 32 * k + 8 * g), a); }
        v2u o; o.x = pk2(a[0] * inv, a[1] * inv); o.y = pk2(a[2] * inv, a[3] * inv);
        *(v2u*)((bf16*)(F.ws + WS_ATT) + row * 1024 + h * 256 + 32 * w + 16 * th + 4 * g) = o; }
    __syncthreads();
}
__device__ __forceinline__ void cg_unpack(const v4u a, float (&o)[8]) { o[0] = bflo(a.x); o[1] = bfhi(a.x); o[2] = bflo(a.y); o[3] = bfhi(a.y); o[4] = bflo(a.z); o[5] = bfhi(a.z); o[6] = bflo(a.w); o[7] = bfhi(a.w); }
template <int NROWS> __device__ __forceinline__ void convgate_task(FA, int l, int run, int chk) {
    const int j0 = chk * 8, row0 = run * 16;
    const bool samp = row0 >= MP; const int sb = (row0 - MP) >> 4;
    const bf16* U = (const bf16*)(F.ws + WS_BIG);
    const float* wf = INP(I_WFC) + (size_t)l * 3 * NUP;
    float wg[3][8], wv[3][8];
#pragma unroll
    for (int d = 0; d < 3; ++d) { const f32x4 a0 = *(const f32x4*)(wf + d * NUP + j0), a1 = *(const f32x4*)(wf + d * NUP + j0 + 4), b0 = *(const f32x4*)(wf + d * NUP + DFF + j0), b1 = *(const f32x4*)(wf + d * NUP + DFF + j0 + 4);
#pragma unroll
        for (int j = 0; j < 4; ++j) { wg[d][j] = a0[j]; wg[d][4 + j] = a1[j]; wv[d][j] = b0[j]; wv[d][4 + j] = b1[j]; } }
    float g2[8], g1[8], v2[8], v1[8];
    if (samp) { const float* st = INP(I_SFFN) + ((size_t)(l * 16 + sb) * 2) * NUP + j0;
#pragma unroll
        for (int j = 0; j < 8; ++j) { g2[j] = st[j]; v2[j] = st[DFF + j]; g1[j] = st[NUP + j]; v1[j] = st[NUP + DFF + j]; } }
    else if ((row0 & (SEQ - 1)) == 0) {
#pragma unroll
        for (int j = 0; j < 8; ++j) { g2[j] = 0.f; g1[j] = 0.f; v2[j] = 0.f; v1[j] = 0.f; } }
    else { const bf16* p2 = U + (size_t)(row0 - 2) * NUP + j0; cg_unpack(*(const v4u*)p2, g2); cg_unpack(*(const v4u*)(p2 + DFF), v2); cg_unpack(*(const v4u*)(p2 + NUP), g1); cg_unpack(*(const v4u*)(p2 + NUP + DFF), v1); }
    const bf16* pu = launder_g(U + (size_t)row0 * NUP + j0);
    bf16* pg = launder_g((bf16*)(F.ws + WS_GREG) + (size_t)row0 * DFF + j0);
#pragma unroll 2
    for (int r = 0; r < NROWS; ++r) {
        float g0[8], v0[8]; cg_unpack(*(const v4u*)pu, g0); cg_unpack(*(const v4u*)(pu + DFF), v0);
        float o[8];
#pragma unroll
        for (int j = 0; j < 8; ++j) { const float yg = (wg[0][j] * g2[j] + wg[1][j] * g1[j]) + wg[2][j] * g0[j], yv = (wv[0][j] * v2[j] + wv[1][j] * v1[j]) + wv[2][j] * v0[j]; o[j] = silu_f(yg) * yv;
            g2[j] = g1[j]; g1[j] = g0[j]; v2[j] = v1[j]; v1[j] = v0[j]; }
        v4u ow; ow.x = pk2(o[0], o[1]); ow.y = pk2(o[2], o[3]); ow.z = pk2(o[4], o[5]); ow.w = pk2(o[6], o[7]);
        *(v4u*)pg = ow;
        pu += NUP; pg += DFF;
    }
}
template <int MODE> __device__ __forceinline__ void skinny_item(FA, const bf16* Asmp, const bf16* Bt, int K, int item, const float* Xs, float* Yo) {
    const int lane = F.lane, w = F.wave, g = lane >> 4, n = lane & 15;
    const int mg = item >> 4, nt = item & 15, j = w & 3, kh = w >> 2, Ks = K >> 3, ns = Ks >> 5;
    const bf16* ap = Asmp + (size_t)(mg * 16 + n) * K + w * Ks + 8 * g;
    const bf16* bp = Bt + (size_t)(nt * 64 + n) * K + w * Ks + 8 * g;
    const size_t bs = (size_t)16 * K;
    float pre[4] = {0.f, 0.f, 0.f, 0.f};
    if (kh == 0) {
#pragma unroll
        for (int r = 0; r < 4; ++r) { const size_t row = (size_t)MP + mg * 16 + 4 * g + r; const size_t o = row * 1024 + nt * 64 + 16 * j + n;
            if (MODE == 0) pre[r] = Xs ? Xs[o - (size_t)MP * 1024] : bf2f(((const bf16*)(F.ws + WS_HB))[o]);
            else pre[r] = pg8::row_scale16((const float*)(F.ws + WS_SS), (int)row, 1.0f / 1024.0f); } }
    f32x4 cc[4];
#pragma unroll
    for (int t = 0; t < 4; ++t) cc[t] = (f32x4){0.f, 0.f, 0.f, 0.f};
    for (int s0 = 0; s0 < ns; s0 += 6) {
        bf16x8 a[6], b[6][4];
#pragma unroll
        for (int u = 0; u < 6; ++u) if (s0 + u < ns) { a[u] = *(const bf16x8*)(ap + (s0 + u) * 32);
#pragma unroll
            for (int t = 0; t < 4; ++t) b[u][t] = *(const bf16x8*)(bp + t * bs + (s0 + u) * 32); }
#pragma unroll
        for (int u = 0; u < 6; ++u) if (s0 + u < ns) {
#pragma unroll
            for (int t = 0; t < 4; ++t) cc[t] = mfma16(a[u], b[u][t], cc[t]); }
    }
    LAS f32x4* RED = (LAS f32x4*)F.lds;
    LAS float* PART = (LAS float*)(F.lds + 32768);
#pragma unroll
    for (int t = 0; t < 4; ++t) RED[(w * 4 + t) * 64 + lane] = cc[t];
    __syncthreads();
    float* SS = (float*)(F.ws + WS_SS);
    if (kh == 0) {
        f32x4 c = RED[j * 64 + lane];
#pragma unroll
        for (int sl = 1; sl < 8; ++sl) c = c + RED[(sl * 4 + j) * 64 + lane];
#pragma unroll
        for (int r = 0; r < 4; ++r) {
            const int lr = 4 * g + r; const size_t row = (size_t)MP + mg * 16 + lr; const size_t o = row * 1024 + nt * 64 + 16 * j + n;
            float q;
            if (MODE == 0) {
                bf16* HB = (bf16*)(F.ws + WS_HB);
                const float h0 = pre[r] + c[r];
                if (Yo) Yo[o] = h0; else HB[o] = f2bf(h0);
                q = h0 * h0;
            } else {
                const float v0 = c[r] * pre[r]; ((bf16*)(F.ws + WS_QATT))[o] = f2bf(v0);
                q = v0 * v0;
            }
            q = xadd<1>(q); q = xadd<2>(q); q = xadd<4>(q); q = xadd<8>(q);
            if (n == 0) PART[lr * 4 + j] = q;
        }
    }
    __syncthreads();
    if (F.tid < 16) { const size_t row = (size_t)MP + mg * 16 + F.tid; float* dst = (MODE == 0) ? SS : (float*)(F.ws + WS_QSS);
        dst[row * 16 + nt] = (PART[F.tid * 4] + PART[F.tid * 4 + 1]) + (PART[F.tid * 4 + 2] + PART[F.tid * 4 + 3]); }
    __syncthreads();
}
constexpr int PH_PER_LAYER = 9, N_PHASES = 1 + DEPTH * PH_PER_LAYER;
#ifndef GDN_REP_PREP
#define GDN_REP_PREP 1
#endif
#ifndef GDN_REP_SCAN
#define GDN_REP_SCAN 1
#endif
#ifndef GDN_REP_O
#define GDN_REP_O 1
#endif
#ifndef GDN_REP_MID
#define GDN_REP_MID 1
#endif
#ifndef GDN_SPLIT_P
#define GDN_SPLIT_P 0
#endif
#ifndef GDN_SPLIT_O
#define GDN_SPLIT_O 0
#endif
#ifndef REP_MASK
#define REP_MASK 0
#endif
#ifndef REP_N
#define REP_N 2
#endif
#ifndef MIX_MASK
#define MIX_MASK 127
#endif
#ifndef PH_MASK
#define PH_MASK 1023
#endif
#ifndef MK_ONE_LAUNCH
#define MK_ONE_LAUNCH 1
#endif
#define LAUNDER_FRAME() do { unsigned long long w_ = (unsigned long long)A.ws, o_ = (unsigned long long)A.out, k_ = (unsigned long long)__builtin_amdgcn_kernarg_segment_ptr(); int t_ = threadIdx.x, b_ = blockIdx.x, g_ = gridDim.x; \
        asm volatile("" : "+s"(w_), "+s"(o_), "+s"(k_), "+s"(b_), "+s"(g_), "+v"(t_)); F.kp = (const CAS char*)k_; F.ws = (unsigned char*)(GAS unsigned char*)w_; F.out = (float*)(GAS float*)o_; \
        F.tid = t_; F.lane = t_ & 63; F.wave = __builtin_amdgcn_readfirstlane(t_ >> 6); F.bid = b_; F.G = g_; F.ctl = (unsigned*)(F.ws + WS_CTL); } while (0)
__global__ void __launch_bounds__(NWAVES * 64, 2) fwd(Args A) {
    extern __shared__ __attribute__((aligned(16))) unsigned char lds[];
    Frame F;
    F.lds = (LAS unsigned char*)lds;
    F.MISC = (volatile LAS unsigned*)(F.lds + MISC_OFF);
    F.tid = threadIdx.x; F.lane = F.tid & 63; F.wave = __builtin_amdgcn_readfirstlane(F.tid >> 6);
    F.G = gridDim.x; F.bid = blockIdx.x;
    F.out = A.out; F.ws = A.ws; F.ctl = (unsigned*)(A.ws + WS_CTL);
    for (int u = F.tid; u < (LDS_BYTES - LDSCTL_OFF) / 4; u += NWAVES * 64) ((LAS unsigned*)(F.lds + LDSCTL_OFF))[u] = 0u;
    __syncthreads();
    XcdBarrier bar; bar.bar = F.ctl + CW_BAR; bar.x = 0; bar.st = nullptr;
    const bool multi = (A.ph_hi - A.ph_lo) > 1;
    if (multi) bar = xcd_barrier_post(F.ctl + CW_BAR, F.MISC + 8);

    for (int ph = A.ph_lo; ph < A.ph_hi; ++ph) {
        if (ph == 0) { LAUNDER_FRAME(); if (PH_MASK & 1) p_prologue(F, A); }
        else {
            const int l = (ph - 1) / PH_PER_LAYER, kind = (ph - 1) % PH_PER_LAYER;
            const int reps = ((REP_MASK >> kind) & 1) ? REP_N : 1;
            for (int rep = 0; rep < reps; ++rep) {
            if (kind == 0 && (PH_MASK & 2)) {
                LAUNDER_FRAME(); bf16* HB = (bf16*)(F.ws + WS_HB); float* SS = (float*)(F.ws + WS_SS); unsigned char* wb = wbuf(F, l); const int gw = F.bid * NWAVES + F.wave, NGW = F.G * NWAVES; (void)HB; (void)SS; (void)wb; (void)gw; (void)NGW;
                pg8::Gemm gm{HB, (const bf16*)(wb + WB_WIN), M, NPROJ, 1024}; pg8::StaticOrder S; S.init(M, NPROJ, F.G, F.bid);
                pg8::EpiProj E{(bf16*)(F.ws + WS_BIG), NPROJ, SS, (float*)(F.ws + WS_AB), PC_AB / 256};
                pg8::gemm_phase<pg8::EpiProj, pg8::StaticOrder, true, true>(F.lds + RING_OFF, gm, S, E);
                if (l == 0) {
                    pg8::Gemm g2{(const bf16*)(F.ws + WS_MB), (const bf16*)(F.ws + WS_WMKV), 512, 8192, 1024}; pg8::StaticOrder S2; S2.init(512, 8192, F.G, F.G - 1 - F.bid);
                    pg8::EpiMemKV E2{F.out + O_PMK, F.out + O_PMV, (const float*)(F.ws + WS_RM), (float*)(F.ws + WS_KSS)};
                    pg8::gemm_phase<pg8::EpiMemKV, pg8::StaticOrder, true, true>(F.lds + RING_OFF, g2, S2, E2);
                }
            } else if (kind == 1 && (PH_MASK & 4)) {
                LAUNDER_FRAME(); bf16* HB = (bf16*)(F.ws + WS_HB); float* SS = (float*)(F.ws + WS_SS); unsigned char* wb = wbuf(F, l); const int gw = F.bid * NWAVES + F.wave, NGW = F.G * NWAVES; (void)HB; (void)SS; (void)wb; (void)gw; (void)NGW;
#define GDN_IDS() LAUNDER_FRAME(); const bool isscan = F.bid < 16; const int wi = F.bid - 16, NW = F.G - 16, gww = wi * NWAVES + F.wave, NGWW = NW * NWAVES; (void)isscan; (void)wi; (void)NW; (void)gww; (void)NGWW
                { GDN_IDS(); if (isscan) gdn_scan_prompt(F, A, l, F.bid, l * 2 + rep); }
                { GDN_IDS();
                  if (!isscan) { unsigned* pend = nullptr;
                    for (int j = wi; j < NITEM; j += NW) { const int it = gdn_item_of(j); const bool smp = j >= 1024; const int fl_ = l * 2 + rep;
                        gdn_prep_item(F, A, l, it, pend);
                        pend = smp ? nullptr : F.ctl + CW_READY + fl_ * 1024 + (((j >> 2) & 1) * 4 + (j & 3)) * 128 + (j >> 3); }
                    asm volatile("s_waitcnt vmcnt(0)" ::: "memory"); __syncthreads();
                    if (pend && F.tid == 0) __hip_atomic_store(pend, 1u, __ATOMIC_RELAXED, __HIP_MEMORY_SCOPE_AGENT); } }
                { GDN_IDS(); if (!isscan) for (int j = wi; j < NITEM; j += NW) if (j >= 1024) { gdn_sample_scan(F, A, l, j);
                        if (F.tid == 0) __hip_atomic_store(F.ctl + CW_SDONE + (l * 2 + rep) * 64 + (j - 1024), 1u, __ATOMIC_RELAXED, __HIP_MEMORY_SCOPE_AGENT); } }
                { const int fl = l * 2 + rep, Q1 = 0, Q2 = Q1 + 544, Q3 = Q2 + 260, Q3b = Q3 + ((l == 0 && rep == 0) ? 32 : 0), Q4 = Q3b + (CI_LAYER - CI_WIN + 31) / 32, Q5 = Q4 + NITEM;
                  for (;;) {
                    LAUNDER_FRAME();
                    volatile LAS unsigned* qslot = F.MISC + 16;
                    if (F.tid == 0) *qslot = __hip_atomic_fetch_add(F.ctl + CW_QH + fl * 64, 1u, __ATOMIC_RELAXED, __HIP_MEMORY_SCOPE_AGENT);
                    __syncthreads();
                    const int q = __builtin_amdgcn_readfirstlane((int)*qslot);
                    __syncthreads();
                    if (q >= Q5) break;
                    if (q < Q2) swa_item(F, A, l, q - Q1);
                    else if (q < Q3) { const int r0 = (q - Q2) * 64 + F.wave;
#pragma unroll
                        for (int r = 0; r < 8; ++r) sc_row(F, A, l, r0 + 8 * r); }
                    else if (q < Q3b) { const int r0 = (q - Q3) * 64 + F.wave; for (int r = 0; r < 8; ++r) memkv_fix_row(F, A, r0 + 8 * r); }
                    else if (q < Q4) { LAS float* scr = (LAS float*)(F.lds + RING_OFF + F.wave * 16384); const int base = (q - Q3b) * 32 + F.wave * 4;
                           for (int k = 0; k < 4; ++k) if (base + k < CI_LAYER - CI_WIN) conv_layer_item(F, A, l, CI_WIN + base + k, scr);
                           __syncthreads(); }
                    else { const int j = q - Q4, it = gdn_item_of(j); const bool smp = j >= 1024; const int c = j >> 3, b = (j >> 2) & 1, h = j & 3;
                        if (F.wave == 0) {
                            unsigned spins = 0;
                            if (!smp) { const unsigned* prog = F.ctl + CW_PROG + ((fl * 8 + b * 4 + h) * 2) * 64;
                                while ((unsigned)__builtin_amdgcn_readfirstlane(__hip_atomic_load(prog, __ATOMIC_RELAXED, __HIP_MEMORY_SCOPE_AGENT)) < (unsigned)(c + 1) ||
                                       (unsigned)__builtin_amdgcn_readfirstlane(__hip_atomic_load(prog + 64, __ATOMIC_RELAXED, __HIP_MEMORY_SCOPE_AGENT)) < (unsigned)(c + 1)) { __builtin_amdgcn_s_sleep(8); if (++spins > (1u << 20)) break; } }
                            else { const unsigned* sd = F.ctl + CW_SDONE + fl * 64 + (j - 1024);
                                while ((unsigned)__builtin_amdgcn_readfirstlane(__hip_atomic_load(sd, __ATOMIC_RELAXED, __HIP_MEMORY_SCOPE_AGENT)) == 0u) { __builtin_amdgcn_s_sleep(8); if (++spins > (1u << 20)) break; } }
                            __builtin_amdgcn_fence(__ATOMIC_ACQUIRE, "agent"); asm volatile("s_waitcnt vmcnt(0)" ::: "memory"); }
                        __syncthreads();
                        gdn_o_item(F, A, l, it, smp ? MP + ((j - 1024) >> 2) * 16 : b * SEQ + c * 64, smp ? 16 : 64, h); }
                  } }
            } else if ((kind == 2 || kind == 5 || kind == 8) && (PH_MASK & 32)) {
                LAUNDER_FRAME(); bf16* HB = (bf16*)(F.ws + WS_HB); float* SS = (float*)(F.ws + WS_SS); unsigned char* wb = wbuf(F, l); const int gw = F.bid * NWAVES + F.wave, NGW = F.G * NWAVES; (void)HB; (void)SS; (void)wb; (void)gw; (void)NGW;
                const bf16* Ain = (kind == 2) ? (const bf16*)(F.ws + WS_MIX) : (kind == 5) ? (const bf16*)(F.ws + WS_ATT) : (const bf16*)(F.ws + WS_GREG);
                const bf16* Bt = (const bf16*)(wb + ((kind == 2) ? WB_WO : (kind == 5) ? WB_WMO : WB_WDN));
                const int Kd = (kind == 8) ? DFF : 1024;
                pg8::Gemm gm{Ain, Bt, MP, 1024, Kd}; pg8::StaticOrder S; S.init(MP, 1024, F.G, F.bid);
                pg8::EpiResid E{(l == 0 && kind == 2) ? INP(I_XP) : nullptr, HB, (l == DEPTH - 1 && kind == 8) ? F.out : nullptr, SS};
                pg8::gemm_phase<pg8::EpiResid, pg8::StaticOrder, true, true>(F.lds + RING_OFF, gm, S, E);
                for (int it = F.G - 1 - F.bid; it < 256; it += F.G) skinny_item<0>(F, A, Ain + (size_t)MP * Kd, Bt, Kd, it, (l == 0 && kind == 2) ? INP(I_XS) : nullptr, (l == DEPTH - 1 && kind == 8) ? F.out : nullptr);
            } else if (kind == 3 && (PH_MASK & 64)) {
                LAUNDER_FRAME(); bf16* HB = (bf16*)(F.ws + WS_HB); float* SS = (float*)(F.ws + WS_SS); unsigned char* wb = wbuf(F, l); const int gw = F.bid * NWAVES + F.wave, NGW = F.G * NWAVES; (void)HB; (void)SS; (void)wb; (void)gw; (void)NGW;
                pg8::Gemm gm{HB, (const bf16*)(wb + WB_WMQ), MP, 1024, 1024}; pg8::StaticOrder S; S.init(MP, 1024, F.G, F.bid);
                pg8::EpiQ E{(bf16*)(F.ws + WS_QATT), SS, (float*)(F.ws + WS_QSS)};
                pg8::gemm_phase<pg8::EpiQ, pg8::StaticOrder, true, true>(F.lds + RING_OFF, gm, S, E);
                for (int it = F.G - 1 - F.bid; it < 256; it += F.G) skinny_item<1>(F, A, HB + (size_t)MP * 1024, (const bf16*)(wb + WB_WMQ), 1024, it, nullptr, nullptr);
            } else if (kind == 4 && (PH_MASK & 128)) {
                LAUNDER_FRAME(); bf16* HB = (bf16*)(F.ws + WS_HB); float* SS = (float*)(F.ws + WS_SS); unsigned char* wb = wbuf(F, l); const int gw = F.bid * NWAVES + F.wave, NGW = F.G * NWAVES; (void)HB; (void)SS; (void)wb; (void)gw; (void)NGW;
                if (F.bid >= F.G - 64) xattn_sample_item(F, A, l, F.bid - (F.G - 64));
                { const int fl = l * 2 + rep, NCT = (l + 1 < DEPTH) ? (CI_WIN + 31) / 32 : 0, Q1 = 0, Q2 = Q1, Q3 = Q2 + NCT;
                  for (;;) {
                    LAUNDER_FRAME();
                    volatile LAS unsigned* qslot = F.MISC + 16;
                    if (F.tid == 0) *qslot = __hip_atomic_fetch_add(F.ctl + CW_QH + (8 + fl) * 64, 1u, __ATOMIC_RELAXED, __HIP_MEMORY_SCOPE_AGENT);
                    __syncthreads();
                    const int q = __builtin_amdgcn_readfirstlane((int)*qslot);
                    __syncthreads();
                    if (q >= Q3) break;
                    { LAS float* scr = (LAS float*)(F.lds + RING_OFF + F.wave * 16384); const int base = (q - Q2) * 32 + F.wave * 4;
                           for (int k = 0; k < 4; ++k) if (base + k < CI_WIN) conv_layer_item(F, A, l + 1, base + k, scr);
                           __syncthreads(); }
                  } }
            } else if (kind == 6 && (PH_MASK & 256)) {
                LAUNDER_FRAME(); bf16* HB = (bf16*)(F.ws + WS_HB); float* SS = (float*)(F.ws + WS_SS); unsigned char* wb = wbuf(F, l); const int gw = F.bid * NWAVES + F.wave, NGW = F.G * NWAVES; (void)HB; (void)SS; (void)wb; (void)gw; (void)NGW;
                pg8::Gemm gm{HB, (const bf16*)(wb + WB_WUP), M, NUP, 1024}; pg8::StaticOrder S; S.init(M, NUP, F.G, F.bid);
                pg8::EpiUp E{(bf16*)(F.ws + WS_GREG), (bf16*)(F.ws + WS_BIG), SS, INP(I_WFC) + (size_t)l * 3 * NUP, F.out, l};
                pg8::gemm_phase<pg8::EpiUp, pg8::StaticOrder, true, true>(F.lds + RING_OFF, gm, S, E);
            } else if (kind == 7 && (PH_MASK & 512)) {
                LAUNDER_FRAME(); bf16* HB = (bf16*)(F.ws + WS_HB); float* SS = (float*)(F.ws + WS_SS); unsigned char* wb = wbuf(F, l); const int gw = F.bid * NWAVES + F.wave, NGW = F.G * NWAVES; (void)HB; (void)SS; (void)wb; (void)gw; (void)NGW;
                const int NG = MP / 64 + MS / 16;
                const int NT = NG * (DFF / 8), gt = F.bid * (NWAVES * 64) + F.tid, GT = F.G * NWAVES * 64;
                for (int t = gt; t < NT; t += GT) { const int gi = t / (DFF / 8), chk = t - gi * (DFF / 8); const int run = (gi < MP / 64) ? gi * 4 : (MP / 16 + (gi - MP / 64)); convgate_task<2>(F, A, l, run, chk); }
            }
            if (kind == 3 && (PH_MASK & 64)) {
                LAUNDER_FRAME();
                const int L = F.bid & 255, wg = (L & 7) * 32 + (L >> 3), pm_ = (wg >> 5) * 8 + (wg & 7), pn_ = (wg & 31) >> 3;
                v4u kr[16]; xattn_k_issue(F, A, l, pm_, pn_, kr);
                asm volatile("s_waitcnt vmcnt(0)" ::: "memory"); __syncthreads();
                if (F.wave == 0) { __builtin_amdgcn_fence(__ATOMIC_ACQUIRE, "agent"); asm volatile("s_waitcnt vmcnt(0)" ::: "memory"); }
                __syncthreads();
                xattn_prompt_item(F, A, l, pm_, pn_, kr);
            }
            }
        }
        if (ph + 1 < A.ph_hi) xcd_barrier(bar);
    }
}

extern "C" void kernel_launch(void* const* d_in, const int* in_sizes, int n_in, void* d_out, int out_size, void* d_ws, size_t ws_size, hipStream_t stream) {
    static int grid = 0;
    if (grid == 0) {
        if (n_in != N_IN || in_sizes[0] != MP * DM || (size_t)out_size != O_END || ws_size < WS_END) {
            fprintf(stderr, "kernel_launch: unexpected shapes: n_in %d in0 %d out %d ws %zu (need %zu); nothing launched\n", n_in, n_in > 0 ? in_sizes[0] : -1, out_size, ws_size, (size_t)WS_END); grid = -1; return; }
        int dev = 0, cus = 0, per_cu = 0;
        if (hipGetDevice(&dev) != hipSuccess || hipDeviceGetAttribute(&cus, hipDeviceAttributeMultiprocessorCount, dev) != hipSuccess) { grid = -1; return; }
        if (hipFuncSetAttribute((const void*)fwd, hipFuncAttributeMaxDynamicSharedMemorySize, LDS_BYTES) != hipSuccess) { fprintf(stderr, "kernel_launch: hipFuncSetAttribute failed\n"); grid = -1; return; }
        if (hipOccupancyMaxActiveBlocksPerMultiprocessor(&per_cu, (const void*)fwd, NWAVES * 64, LDS_BYTES) != hipSuccess || per_cu < 1) fprintf(stderr, "kernel_launch: occupancy query says %d\n", per_cu);
        (void)hipGetLastError();
        if (cus < 256) { fprintf(stderr, "kernel_launch: %d CUs, this kernel's tile-to-workgroup maps need 256; nothing launched\n", cus); grid = -1; return; }
        grid = 256;
    }
    if (grid < 0) return;
    (void)hipMemsetAsync((char*)d_ws + WS_CTL, 0, CTL_ZERO_BYTES, stream);
    Args a{};
    for (int i = 0; i < N_IN; ++i) a.in[i] = (const float*)d_in[i];
    a.out = (float*)d_out; a.ws = (unsigned char*)d_ws;
#if MK_ONE_LAUNCH
    a.ph_lo = 0; a.ph_hi = N_PHASES;
    hipLaunchKernelGGL(fwd, dim3(grid), dim3(NWAVES * 64), LDS_BYTES, stream, a);
#else
    for (int ph = 0; ph < N_PHASES; ++ph) { a.ph_lo = ph; a.ph_hi = ph + 1; hipLaunchKernelGGL(fwd, dim3(grid), dim3(NWAVES * 64), LDS_BYTES, stream, a); }
#endif
}
```
